# Optimizing an MI355X kernel written in HIP

```python
import math
import jax, jax.numpy as jnp
from jax import lax
import numpy as np

D_MODEL = 1024
BATCH = 1
SEQ = 16384
DEPTH = 4
DEC_BATCH = 4
DEC_SEQ = 4096
PAST_LEN = 128

D_MIX = D_MODEL
CONV_W = D_MODEL // 4
CONV_KERNEL = 31
CONV_PAD = CONV_KERNEL // 2
POOL_W = D_MODEL // 4
POOL_WINDOWS = (2, 4, 8, 16)
N_POOL_GROUPS = len(POOL_WINDOWS)
POOL_GW = POOL_W // N_POOL_GROUPS
ATTN_W = D_MIX - CONV_W - POOL_W
N_HEADS = 4
V_HEAD_DIM = ATTN_W // N_HEADS
QK_NOPE_DIM = 128
QK_ROPE_DIM = 64
QK_HEAD_DIM = QK_NOPE_DIM + QK_ROPE_DIM
Q_LORA_RANK = 256
KV_LORA_RANK = 128
ROPE_BASE = 10000.0
Q_BLOCK = 128
D_IN = 2 * CONV_W + POOL_W + Q_LORA_RANK + KV_LORA_RANK + QK_ROPE_DIM
D_FF = ((8 * D_MODEL + 3 * 256 - 1) // (3 * 256)) * 256
ALPHA = (2.0 * DEPTH) ** 0.25
BETA = (8.0 * DEPTH) ** -0.25
LN_EPS = 1e-5
RMS_EPS = 1e-6

kernel_name = "hybrid_conv_pool_mla_deepnorm_encoder"


def layer_norm(x, g, b):
    xf = x.astype(jnp.float32)
    mu = jnp.mean(xf, axis=-1, keepdims=True)
    xc = xf - mu
    var = jnp.mean(xc * xc, axis=-1, keepdims=True)
    return (xc * lax.rsqrt(var + LN_EPS) * g + b).astype(x.dtype)


def rms_norm(x, g):
    xf = x.astype(jnp.float32)
    ms = jnp.mean(xf * xf, axis=-1, keepdims=True)
    return (xf * lax.rsqrt(ms + RMS_EPS) * g).astype(x.dtype)


def rope_tables(S):
    pos = jnp.arange(S, dtype=jnp.float32)
    inv_freq = 1.0 / (ROPE_BASE ** (jnp.arange(0, QK_ROPE_DIM, 2, dtype=jnp.float32) / QK_ROPE_DIM))
    ang = pos[:, None] * inv_freq[None, :]
    return jnp.cos(ang), jnp.sin(ang)


def apply_rope(x, cos, sin):
    x1, x2 = jnp.split(x, 2, axis=-1)
    out = jnp.concatenate([x1 * cos - x2 * sin, x1 * sin + x2 * cos], axis=-1)
    return out.astype(x.dtype)


def conv_module(u, w_dw, b_dw, g_cn, b_cn, w_pw):
    a, gate = jnp.split(u, 2, axis=-1)
    h = a * jax.nn.sigmoid(gate)
    h = lax.conv_general_dilated(
        h, w_dw[:, None, :].astype(h.dtype), window_strides=(1,), padding=[(CONV_PAD, CONV_PAD)],
        dimension_numbers=("NWC", "WIO", "NWC"), feature_group_count=CONV_W) + b_dw
    h = jax.nn.silu(layer_norm(h, g_cn, b_cn))
    return h @ w_pw


def pool_mixer(p, w_pool, pool_scale):
    B, S, C = p.shape
    pf = p.astype(jnp.float32)
    cs = jnp.concatenate([jnp.zeros((B, 1, C), jnp.float32), jnp.cumsum(pf, axis=1)], axis=1)
    t = jnp.arange(S)
    means = []
    for g, w in enumerate(POOL_WINDOWS):
        left = w // 2
        right = w - 1 - left
        lo = jnp.clip(t - left, 0, S)
        hi = jnp.clip(t + right + 1, 0, S)
        csg = cs[..., g * POOL_GW:(g + 1) * POOL_GW]
        window_sum = jnp.take(csg, hi, axis=1) - jnp.take(csg, lo, axis=1)
        means.append(window_sum / (hi - lo).astype(jnp.float32)[None, :, None])
    d = (jnp.concatenate(means, axis=-1) - pf).astype(p.dtype)
    d = d.reshape(B, S, N_POOL_GROUPS, POOL_GW)
    y = jnp.einsum('bsgc,gcd->bsgd', d, w_pool).reshape(B, S, C)
    return y * pool_scale


def mla(c_q, c_kv, k_rope, g_q, g_kv, w_uq, w_ukv, cos, sin):
    B, S, _ = c_q.shape
    q = (rms_norm(c_q, g_q) @ w_uq).reshape(B, S, N_HEADS, QK_HEAD_DIM)
    q_nope = q[..., :QK_NOPE_DIM]
    q_rope = apply_rope(q[..., QK_NOPE_DIM:], cos[None, :, None, :], sin[None, :, None, :])
    kv = (rms_norm(c_kv, g_kv) @ w_ukv).reshape(B, S, N_HEADS, QK_NOPE_DIM + V_HEAD_DIM)
    k_nope = kv[..., :QK_NOPE_DIM]
    v = kv[..., QK_NOPE_DIM:]
    k_r = apply_rope(k_rope, cos[None], sin[None])
    scale = QK_HEAD_DIM ** -0.5
    nb = S // Q_BLOCK
    qn = q_nope.reshape(B, nb, Q_BLOCK, N_HEADS, QK_NOPE_DIM).transpose(1, 0, 2, 3, 4)
    qr = q_rope.reshape(B, nb, Q_BLOCK, N_HEADS, QK_ROPE_DIM).transpose(1, 0, 2, 3, 4)

    def attend_block(args):
        qn_b, qr_b = args
        s = (jnp.einsum('bqhd,bkhd->bhqk', qn_b, k_nope)
             + jnp.einsum('bqhr,bkr->bhqk', qr_b, k_r))
        pr = jax.nn.softmax(s.astype(jnp.float32) * scale, axis=-1).astype(v.dtype)
        return jnp.einsum('bhqk,bkhd->bqhd', pr, v)

    o = lax.map(attend_block, (qn, qr))
    return o.transpose(1, 0, 2, 3, 4).reshape(B, S, ATTN_W)


def encoder_layer(x, cos, sin, w_in, w_dw, b_dw, g_cn, b_cn, w_pw, w_pool, pool_scale,
                  g_q, g_kv, w_uq, w_ukv, w_out, ln1_g, ln1_b, w_gate, w_up, w_down, ln2_g, ln2_b):
    u = x @ w_in
    o0 = 2 * CONV_W
    o1 = o0 + POOL_W
    o2 = o1 + Q_LORA_RANK
    o3 = o2 + KV_LORA_RANK
    y_conv = conv_module(u[..., :o0], w_dw, b_dw, g_cn, b_cn, w_pw)
    y_pool = pool_mixer(u[..., o0:o1], w_pool, pool_scale)
    y_attn = mla(u[..., o1:o2], u[..., o2:o3], u[..., o3:], g_q, g_kv, w_uq, w_ukv, cos, sin)
    mix = jnp.concatenate([y_conv, y_pool, y_attn], axis=-1) @ w_out
    x = layer_norm(ALPHA * x + mix, ln1_g, ln1_b)
    h = (jax.nn.silu(x @ w_gate) * (x @ w_up)) @ w_down
    return layer_norm(ALPHA * x + h, ln2_g, ln2_b)


def trunk(x, w_in, w_dw, b_dw, g_cn, b_cn, w_pw, w_pool, pool_scale, g_q, g_kv, w_uq, w_ukv,
          w_out, ln1_g, ln1_b, w_gate, w_up, w_down, ln2_g, ln2_b):
    cos, sin = rope_tables(x.shape[1])
    for l in range(DEPTH):
        x = encoder_layer(x, cos, sin, w_in[l], w_dw[l], b_dw[l], g_cn[l], b_cn[l], w_pw[l],
                          w_pool[l], pool_scale[l], g_q[l], g_kv[l], w_uq[l], w_ukv[l], w_out[l],
                          ln1_g[l], ln1_b[l], w_gate[l], w_up[l], w_down[l], ln2_g[l], ln2_b[l])
    return x


def setup_inputs(seed: int = 0) -> dict:
    key = jax.random.key(seed)
    ks = jax.random.split(key, 24)
    f32 = jnp.float32

    def nrm(k, shape, s):
        return jax.random.normal(k, shape, f32) * s

    def gain(k, shape):
        return 1.0 + 0.02 * jax.random.normal(k, shape, f32)

    L = DEPTH
    return {
        "x_prompt": jax.random.normal(ks[0], (BATCH, SEQ, D_MODEL), f32),
        "x_sample": jax.random.normal(ks[1], (DEC_BATCH, DEC_SEQ, D_MODEL), f32),
        "w_in": nrm(ks[2], (L, D_MODEL, D_IN), D_MODEL ** -0.5),
        "w_dw": nrm(ks[3], (L, CONV_KERNEL, CONV_W), CONV_KERNEL ** -0.5),
        "b_dw": nrm(ks[4], (L, CONV_W), 0.01),
        "g_cn": gain(ks[5], (L, CONV_W)),
        "b_cn": nrm(ks[6], (L, CONV_W), 0.01),
        "w_pw": nrm(ks[7], (L, CONV_W, CONV_W), CONV_W ** -0.5),
        "w_pool": nrm(ks[8], (L, N_POOL_GROUPS, POOL_GW, POOL_GW), POOL_GW ** -0.5),
        "pool_scale": 1.0 + 0.1 * jax.random.normal(ks[9], (L, POOL_W), f32),
        "g_q": gain(ks[10], (L, Q_LORA_RANK)),
        "g_kv": gain(ks[11], (L, KV_LORA_RANK)),
        "w_uq": nrm(ks[12], (L, Q_LORA_RANK, N_HEADS * QK_HEAD_DIM), Q_LORA_RANK ** -0.5),
        "w_ukv": nrm(ks[13], (L, KV_LORA_RANK, N_HEADS * (QK_NOPE_DIM + V_HEAD_DIM)), KV_LORA_RANK ** -0.5),
        "w_out": nrm(ks[14], (L, D_MIX, D_MODEL), BETA * D_MIX ** -0.5),
        "ln1_g": gain(ks[15], (L, D_MODEL)),
        "ln1_b": nrm(ks[16], (L, D_MODEL), 0.01),
        "w_gate": nrm(ks[17], (L, D_MODEL, D_FF), D_MODEL ** -0.5),
        "w_up": nrm(ks[18], (L, D_MODEL, D_FF), D_MODEL ** -0.5),
        "w_down": nrm(ks[19], (L, D_FF, D_MODEL), BETA * D_FF ** -0.5),
        "ln2_g": gain(ks[20], (L, D_MODEL)),
        "ln2_b": nrm(ks[21], (L, D_MODEL), 0.01),
    }


def reference(x_prompt, x_sample, w_in, w_dw, b_dw, g_cn, b_cn, w_pw, w_pool, pool_scale,
              g_q, g_kv, w_uq, w_ukv, w_out, ln1_g, ln1_b, w_gate, w_up, w_down, ln2_g, ln2_b):
    y_prompt = trunk(x_prompt, w_in, w_dw, b_dw, g_cn, b_cn, w_pw, w_pool, pool_scale, g_q, g_kv,
                     w_uq, w_ukv, w_out, ln1_g, ln1_b, w_gate, w_up, w_down, ln2_g, ln2_b)
    y_sample = trunk(x_sample, w_in, w_dw, b_dw, g_cn, b_cn, w_pw, w_pool, pool_scale, g_q, g_kv,
                     w_uq, w_ukv, w_out, ln1_g, ln1_b, w_gate, w_up, w_down, ln2_g, ln2_b)
    return (y_prompt, y_sample)
```

```cpp
#include <hip/hip_runtime.h>
#include <hip/hip_cooperative_groups.h>
#include <cstdio>
#include <cstdint>
#include <cmath>
namespace cg = cooperative_groups;

#define LAS __attribute__((address_space(3)))
typedef _Float16 f16;
typedef _Float16 half8 __attribute__((ext_vector_type(8)));
typedef _Float16 half4 __attribute__((ext_vector_type(4)));
typedef _Float16 half2v __attribute__((ext_vector_type(2)));
typedef short s16x8 __attribute__((ext_vector_type(8)));
typedef short s16x4 __attribute__((ext_vector_type(4)));
typedef float f32x2 __attribute__((ext_vector_type(2)));
typedef float f32x4 __attribute__((ext_vector_type(4)));
typedef float f32x16 __attribute__((ext_vector_type(16)));
typedef unsigned u32x4 __attribute__((ext_vector_type(4)));
typedef unsigned u32x2 __attribute__((ext_vector_type(2)));

constexpr int T = 32768, TP = 16384, DM = 1024, DINP = 1280, DFF = 2816, NL = 4;
constexpr int LDQ = 768, LDK = 768, LDV = 512, LDC = 1024, LDU = 1280;
constexpr float ALPHA = 1.6817928305074290f;
constexpr float LN_EPS = 1e-5f, RMS_EPS = 1e-6f;
constexpr float QSCALE = 0.07216878364870323f * 1.4426950408889634f;
constexpr size_t MiB = 1u << 20;
constexpr size_t WS_SSQ_Q = 0, WS_SSQ_KV = 128 * 1024;
constexpr size_t WS_CNT = 256 * 1024;
constexpr size_t WS_BAR = 512 * 1024;
constexpr size_t WS_COS = 1 * MiB, WS_SIN = 3 * MiB;
constexpr size_t WS_WIN = 5 * MiB, WS_WUQ = WS_WIN + (size_t)DINP * DM * 2, WS_WUKV = WS_WUQ + 768 * 256 * 2, WS_WOUT = WS_WUKV + 1024 * 128 * 2;
constexpr size_t WS_WGU = 11 * MiB, WS_WD = 22 * MiB;
constexpr size_t WS_U = 28 * MiB;
constexpr size_t WS_H = 108 * MiB;
constexpr size_t WS_K = WS_H, WS_V = WS_H + 48 * MiB, WS_CAT = WS_H + 80 * MiB;
constexpr size_t WS_XBUF = 284 * MiB;
constexpr size_t WS_END = 285 * MiB;
static_assert(WS_WOUT + (size_t)DM * DM * 2 <= WS_WGU && WS_WD + (size_t)DM * DFF * 2 <= WS_U, "ws map");
constexpr size_t DO_XH = 0, DO_Q = 64 * MiB;

struct Params { const float* in[22]; float* out; unsigned char* ws; float invf[32]; int ph_lo, ph_hi; };
enum { I_XP = 0, I_XS, I_WIN, I_WDW, I_BDW, I_GCN, I_BCN, I_WPW, I_WPOOL, I_PSC, I_GQ, I_GKV, I_WUQ, I_WUKV, I_WOUT, I_LN1G, I_LN1B, I_WG, I_WU, I_WD, I_LN2G, I_LN2B };

__device__ __forceinline__ unsigned cvtpk(float lo, float hi) { f32x2 v = {lo, hi}; half2v h = __builtin_convertvector(v, half2v); return __builtin_bit_cast(unsigned, h); }
__device__ __forceinline__ u32x4 pack8(f32x4 a, f32x4 b) { u32x4 w; w.x = cvtpk(a[0], a[1]); w.y = cvtpk(a[2], a[3]); w.z = cvtpk(b[0], b[1]); w.w = cvtpk(b[2], b[3]); return w; }
typedef int v8i __attribute__((ext_vector_type(8)));
typedef int v4i __attribute__((ext_vector_type(4)));
__device__ __forceinline__ unsigned pk4_fp8(float a, float b, float c, float d) { int w = 0; w = __builtin_amdgcn_cvt_pk_fp8_f32(a, b, w, false); w = __builtin_amdgcn_cvt_pk_fp8_f32(c, d, w, true); return (unsigned)w; }
__device__ __forceinline__ unsigned char one_fp8(float a) { return (unsigned char)(__builtin_amdgcn_cvt_pk_fp8_f32(a, a, 0, false) & 0xFF); }
__device__ __forceinline__ float wave_sum(float v) {
#pragma unroll
    for (int o = 1; o < 64; o <<= 1) v += __shfl_xor(v, o);
    return v;
}
__device__ __forceinline__ int otid() { int t = threadIdx.x; asm volatile("" : "+v"(t)); return t; }
__device__ __forceinline__ int obx() { int t = blockIdx.x; asm volatile("" : "+s"(t)); return t; }
__device__ __forceinline__ int ogd() { int t = gridDim.x; asm volatile("" : "+s"(t)); return t; }
__device__ __forceinline__ int posof(int row) { return row < TP ? row : (row & 4095); }
__device__ __forceinline__ float sigmoidf_(float x) { return __builtin_amdgcn_rcpf(1.0f + __expf(-x)); }

namespace pg8 {
constexpr int BM = 256, BK = 64, HALF = 128, HTB = HALF * BK * 2, STAGE_BYTES = 8 * HTB, NXCD = 8, WGM = 8;
__device__ __forceinline__ int lds_byte(int r, int c) { const int st = (r >> 4) * 2 + (c >> 5), rr = r & 15, cc = c & 31, ob = rr * 64 + cc * 2; return st * 1024 + (ob ^ (((ob >> 9) & 1) << 5)); }
__device__ __forceinline__ void stage_rc(int b, int& R, int& C) { const int st = b / 1024, sb = b % 1024, swz = sb ^ (((sb >> 9) & 1) << 5); R = (st >> 1) * 16 + swz / 64; C = (st & 1) * 32 + (swz % 64) / 2; }
__device__ __forceinline__ int perm32(int rho) { const int n = rho >> 4, i = rho & 15; return 8 * (i >> 2) + 4 * n + (i & 3); }
struct Unit { int pm, pn; };
struct Gemm { const f16* A; const f16* Bt; int lda, ldb, M, N, K; };
struct StaticOrder {
    int nM, nN, nwg, G, c; bool panel = false;
    __device__ void init(int M, int N, int G_, int c_) { nM = M / BM; nN = N / BM; nwg = nM * nN; G = G_; c = c_; }
    __device__ bool next(int i, Unit& u) const {
        if (panel) { const int ge = G & ~3; if (c >= ge) return false; const int idx = i * (ge >> 2) + (c >> 2); if (idx >= nM) return false; u.pm = idx; u.pn = c & 3; return true; }
        const long L = (long)i * G + c; if (L >= nwg) return false;
        int wgid = (int)L; { const int q = nwg / NXCD, r = nwg % NXCD, xcd = wgid % NXCD, off = wgid / NXCD; wgid = (xcd < r ? xcd * (q + 1) : r * (q + 1) + (xcd - r) * q) + off; }
        const int nig = WGM * nN, gid = wgid / nig, fm = gid * WGM, gsz = (nM - fm) < WGM ? (nM - fm) : WGM;
        u.pm = fm + ((wgid % nig) % gsz); u.pn = (wgid % nig) / gsz; return true;
    }
};
template <class Epi>
__device__ __forceinline__ void gemm_phase(LAS unsigned char* lds, const Gemm g, const StaticOrder& S, const Epi& E) {
    const int tid = otid(), wid = __builtin_amdgcn_readfirstlane(tid >> 6), lane = tid & 63, wr = wid >> 2, wc = wid & 3, fr = lane & 15, fq = lane >> 4;
    int nt = g.K / BK; asm volatile("" : "+s"(nt));
    unsigned voffA[2], voffB[2];
#pragma unroll
    for (int i = 0; i < 2; ++i) { int R, C; stage_rc(tid * 16 + i * 8192, R, C); const int Rb = (R & ~31) + perm32(R & 31);
        voffA[i] = (unsigned)(R * g.lda + C) * 2u; voffB[i] = (unsigned)(Rb * g.ldb + C) * 2u; }
    const size_t kstep = (size_t)(BK * 2);
    const size_t hA = (size_t)HALF * g.lda * 2, hB = (size_t)HALF * g.ldb * 2, tA = 2 * hA, tB = 2 * hB;
    const unsigned ldsw = (unsigned)wid * 1024u;
    const int aoff = lds_byte(wr * 64 + fr, fq * 8), boff = lds_byte(wc * 32 + fr, fq * 8);
#define PG8_SA(b, h) (((b) * 2 + (h)) * HTB)
#define PG8_SB(b, h) ((4 + (b) * 2 + (h)) * HTB)
#define PG8_STAGE(bufoff, gbase, voff) do { _Pragma("unroll") for (int _i = 0; _i < 2; ++_i) \
        __builtin_amdgcn_global_load_lds((const unsigned*)((const char*)(gbase) + (voff)[_i]), (LAS unsigned*)(lds + (bufoff) + ldsw + _i * 8192), 16, 0, 0); } while (0)
#define PG8_LDA(dst, b, h) do { _Pragma("unroll") for (int m = 0; m < 4; ++m) _Pragma("unroll") for (int k = 0; k < 2; ++k) dst[m][k] = *(const LAS half8*)(lds + PG8_SA(b, h) + aoff + m * 2048 + k * 1024); } while (0)
#define PG8_LDB(dst, b, h) do { _Pragma("unroll") for (int n = 0; n < 2; ++n) _Pragma("unroll") for (int k = 0; k < 2; ++k) dst[n][k] = *(const LAS half8*)(lds + PG8_SB(b, h) + boff + n * 2048 + k * 1024); } while (0)
#define PG8_MMA(ai, bj, At, Bt) do { __builtin_amdgcn_s_setprio(1); _Pragma("unroll") for (int m = 0; m < 4; ++m) _Pragma("unroll") for (int n = 0; n < 2; ++n) _Pragma("unroll") for (int k = 0; k < 2; ++k) \
        acc[ai][bj][m][n] = __builtin_amdgcn_mfma_f32_16x16x32_f16(Bt[n][k], At[m][k], acc[ai][bj][m][n], 0, 0, 0); __builtin_amdgcn_s_setprio(0); } while (0)
#define PG8_WAIT_V(n) asm volatile("s_waitcnt vmcnt(" #n ")" ::: "memory")
#define PG8_WAIT_L(n) asm volatile("s_waitcnt lgkmcnt(" #n ")" ::: "memory")
#define PG8_BAR __builtin_amdgcn_s_barrier()
#define PG8_SCHED __builtin_amdgcn_sched_barrier(0)
    Unit cur, nxt; int ui = 0;
    if (!S.next(0, cur)) return;
    f32x4 acc[2][2][4][2];
#pragma unroll
    for (int a = 0; a < 2; ++a)
#pragma unroll
        for (int b = 0; b < 2; ++b)
#pragma unroll
            for (int m = 0; m < 4; ++m)
#pragma unroll
                for (int n = 0; n < 2; ++n) acc[a][b][m][n] = (f32x4){0.f, 0.f, 0.f, 0.f};
    half8 At[4][2], B0[2][2], B1[2][2];
    const char* cA = (const char*)g.A + (size_t)cur.pm * tA; const char* cB = (const char*)g.Bt + (size_t)cur.pn * tB;
    PG8_STAGE(PG8_SB(0, 0), cB, voffB); PG8_STAGE(PG8_SB(0, 1), cB + hB, voffB); PG8_STAGE(PG8_SA(0, 0), cA, voffA); PG8_STAGE(PG8_SA(0, 1), cA + hA, voffA);
    if (wr == 1) PG8_BAR;
    PG8_WAIT_V(2); PG8_BAR;
    PG8_STAGE(PG8_SB(1, 0), cB + kstep, voffB); PG8_STAGE(PG8_SA(1, 0), cA + kstep, voffA); PG8_STAGE(PG8_SB(1, 1), cB + hB + kstep, voffB);
    PG8_WAIT_V(6); PG8_BAR;
    for (;;) {
        const bool has_next = S.next(ui + 1, nxt);
        const char* nA = has_next ? (const char*)g.A + (size_t)nxt.pm * tA : cA; const char* nB = has_next ? (const char*)g.Bt + (size_t)nxt.pn * tB : cB;
        for (int t = 0; t < nt; t += 2) {
            const bool last = (t == nt - 2);
            const char* a1 = cA + (size_t)(t + 1) * kstep;
            const char* a2 = last ? nA : cA + (size_t)(t + 2) * kstep; const char* b2 = last ? nB : cB + (size_t)(t + 2) * kstep;
            const char* a3 = a2 + kstep; const char* b3 = b2 + kstep;
            PG8_LDB(B0, 0, 0); PG8_LDB(B1, 0, 1); PG8_SCHED; PG8_LDA(At, 0, 0); PG8_STAGE(PG8_SA(1, 1), a1 + hA, voffA);
            PG8_WAIT_V(8); PG8_WAIT_L(0); PG8_BAR; PG8_MMA(0, 0, At, B0); PG8_MMA(0, 1, At, B1); PG8_BAR; PG8_SCHED;
            PG8_LDA(At, 0, 1); PG8_STAGE(PG8_SB(0, 0), b2, voffB); PG8_STAGE(PG8_SB(0, 1), b2 + hB, voffB); PG8_STAGE(PG8_SA(0, 0), a2, voffA);
            PG8_WAIT_V(8); PG8_WAIT_L(0); PG8_BAR; PG8_MMA(1, 0, At, B0); PG8_MMA(1, 1, At, B1); PG8_BAR; PG8_SCHED;
            PG8_LDB(B0, 1, 0); PG8_LDB(B1, 1, 1); PG8_SCHED; PG8_LDA(At, 1, 0); PG8_STAGE(PG8_SA(0, 1), a2 + hA, voffA);
            PG8_WAIT_V(8); PG8_WAIT_L(0); PG8_BAR; PG8_MMA(0, 0, At, B0); PG8_MMA(0, 1, At, B1); PG8_BAR; PG8_SCHED;
            PG8_LDA(At, 1, 1); PG8_STAGE(PG8_SB(1, 0), b3, voffB); PG8_STAGE(PG8_SB(1, 1), b3 + hB, voffB); PG8_STAGE(PG8_SA(1, 0), a3, voffA);
            PG8_WAIT_V(8); PG8_WAIT_L(0); PG8_BAR; PG8_MMA(1, 0, At, B0); PG8_MMA(1, 1, At, B1); PG8_BAR; PG8_SCHED;
        }
        if (wr == 0) PG8_BAR;
        { const int t2 = otid(), w2 = t2 >> 6, l2 = t2 & 63;
          if constexpr (Epi::FUSED_LN) E.fused(acc, cur, w2 >> 2, w2 & 3, l2 & 15, l2 >> 4, lds + STAGE_BYTES, t2);
          else E(acc, cur, w2 >> 2, w2 & 3, l2 & 15, l2 >> 4); }
        if (!has_next) break;
#pragma unroll
        for (int a = 0; a < 2; ++a)
#pragma unroll
            for (int b = 0; b < 2; ++b)
#pragma unroll
                for (int m = 0; m < 4; ++m)
#pragma unroll
                    for (int n = 0; n < 2; ++n) acc[a][b][m][n] = (f32x4){0.f, 0.f, 0.f, 0.f};
        cur = nxt; cA = nA; cB = nB; ++ui;
        if (wr == 1) PG8_BAR;
    }
    PG8_WAIT_V(0);
    PG8_BAR;
#undef PG8_SA
#undef PG8_SB
#undef PG8_STAGE
#undef PG8_LDA
#undef PG8_LDB
#undef PG8_MMA
#undef PG8_WAIT_V
#undef PG8_WAIT_L
#undef PG8_BAR
#undef PG8_SCHED
}
}
using pg8::Unit;
typedef f32x4 AccT[2][2][4][2];
#define EPI_ROW(u, ai, m) ((u).pm * 256 + (ai) * 128 + wr * 64 + (m) * 16 + fr)
#define EPI_COL(u, bj) ((u).pn * 256 + (bj) * 128 + wc * 32 + 8 * fq)

__device__ __forceinline__ void rope8(f32x4& v0, f32x4& v1, f32x4 c4, f32x4 s4) {
    f32x4 a, b;
    a[0] = v0[0] * c4[0] - v0[1] * s4[0]; a[1] = v0[0] * s4[0] + v0[1] * c4[0];
    a[2] = v0[2] * c4[1] - v0[3] * s4[1]; a[3] = v0[2] * s4[1] + v0[3] * c4[1];
    b[0] = v1[0] * c4[2] - v1[1] * s4[2]; b[1] = v1[0] * s4[2] + v1[1] * c4[2];
    b[2] = v1[2] * c4[3] - v1[3] * s4[3]; b[3] = v1[2] * s4[3] + v1[3] * c4[3];
    v0 = a; v1 = b;
}
__device__ __forceinline__ float sumsq4(f32x4 x) { return (x[0] * x[0] + x[1] * x[1]) + (x[2] * x[2] + x[3] * x[3]); }

struct EpiA {
    static constexpr bool FUSED_LN = false;
    f16* U; float* ssq_q; float* ssq_kv;
    __device__ __forceinline__ void operator()(const AccT& acc, const Unit& u, int wr, int wc, int fr, int fq) const {
#pragma unroll
        for (int ai = 0; ai < 2; ++ai)
#pragma unroll
            for (int m = 0; m < 4; ++m) {
                const int row = EPI_ROW(u, ai, m);
#pragma unroll
                for (int bj = 0; bj < 2; ++bj) *(u32x4*)(U + (size_t)row * LDU + EPI_COL(u, bj)) = pack8(acc[ai][bj][m][0], acc[ai][bj][m][1]);
            }
        if (u.pn >= 3) {
            float* sp = u.pn == 3 ? ssq_q : ssq_kv; const float w1 = u.pn == 3 ? 1.f : 0.f;
#pragma unroll
            for (int ai = 0; ai < 2; ++ai)
#pragma unroll
                for (int m = 0; m < 4; ++m) {
                    float s = (sumsq4(acc[ai][0][m][0]) + sumsq4(acc[ai][0][m][1])) + w1 * (sumsq4(acc[ai][1][m][0]) + sumsq4(acc[ai][1][m][1]));
                    s += __shfl_xor(s, 16); s += __shfl_xor(s, 32);
                    if (fq == 0) unsafeAtomicAdd(sp + EPI_ROW(u, ai, m), s);
                }
        }
    }
};
struct EpiQ {
    static constexpr bool FUSED_LN = false;
    unsigned char* Q; const float* ssq_q; const float* cosT; const float* sinT;
    __device__ __forceinline__ void operator()(const AccT& acc, const Unit& u, int wr, int wc, int fr, int fq) const {
#pragma unroll
        for (int ai = 0; ai < 2; ++ai)
#pragma unroll
            for (int m = 0; m < 4; ++m) {
                const int row = EPI_ROW(u, ai, m);
                const float r = __builtin_amdgcn_rsqf(ssq_q[row] * (1.0f / 256.0f) + RMS_EPS);
                const int pos = posof(row);
#pragma unroll
                for (int bj = 0; bj < 2; ++bj) {
                    const int col = EPI_COL(u, bj), d = col % 192;
                    f32x4 v0 = acc[ai][bj][m][0] * r, v1 = acc[ai][bj][m][1] * r;
                    if (d >= 128) { const int j0 = (d - 128) >> 1;
                        const f32x4 c4 = *(const f32x4*)(cosT + pos * 32 + j0), s4 = *(const f32x4*)(sinT + pos * 32 + j0);
                        rope8(v0, v1, c4, s4); }
                    u32x2 w; w.x = pk4_fp8(v0[0], v0[1], v0[2], v0[3]); w.y = pk4_fp8(v1[0], v1[1], v1[2], v1[3]);
                    *(u32x2*)(Q + (size_t)row * LDQ + col) = w;
                }
            }
    }
};
struct EpiKV {
    static constexpr bool FUSED_LN = false;
    unsigned char* Kb; unsigned char* VT; const float* ssq_kv;
    __device__ __forceinline__ void operator()(const AccT& acc, const Unit& u, int wr, int wc, int fr, int fq) const {
#pragma unroll
        for (int ai = 0; ai < 2; ++ai)
#pragma unroll
            for (int m = 0; m < 4; ++m) {
                const int row = EPI_ROW(u, ai, m);
                const float r = __builtin_amdgcn_rsqf(ssq_kv[row] * (1.0f / 128.0f) + RMS_EPS);
                const int c = wc * 32 + 8 * fq;
                const f32x4 k0 = acc[ai][0][m][0] * r, k1 = acc[ai][0][m][1] * r;
                u32x2 w; w.x = pk4_fp8(k0[0], k0[1], k0[2], k0[3]); w.y = pk4_fp8(k1[0], k1[1], k1[2], k1[3]);
                *(u32x2*)(Kb + (size_t)row * LDK + 192 * u.pn + c) = w;
                const int tile = row >> 6, k = row & 63, a = k >> 5, cc = k & 31, pos = 32 * ((cc >> 2) & 1) + 16 * a + (cc & 3) + 4 * (cc >> 3);
                unsigned char* vt = VT + ((size_t)(u.pn * (T / 64) + tile) * 128 + c) * 64 + (pos & 15);
#pragma unroll
                for (int e = 0; e < 8; ++e) { const float v = (e < 4 ? acc[ai][1][m][0][e & 3] : acc[ai][1][m][1][e & 3]) * r;
                    vt[e * 64 + ((((pos >> 4) ^ (((c + e) >> 2) & 3)) & 3) << 4)] = one_fp8(v); }
            }
    }
};
template <bool F32OUT> struct EpiRes {
    static constexpr bool FUSED_LN = false;
    const f16* res; f16* o16; float* o32;
    __device__ __forceinline__ void operator()(const AccT& acc, const Unit& u, int wr, int wc, int fr, int fq) const {
#pragma unroll
        for (int ai = 0; ai < 2; ++ai)
#pragma unroll
            for (int m = 0; m < 4; ++m) {
                const int row = EPI_ROW(u, ai, m);
#pragma unroll
                for (int bj = 0; bj < 2; ++bj) {
                    const size_t off = (size_t)row * DM + EPI_COL(u, bj);
                    const half8 rv = *(const half8*)(res + off);
                    f32x4 v0 = acc[ai][bj][m][0], v1 = acc[ai][bj][m][1];
#pragma unroll
                    for (int e = 0; e < 4; ++e) { v0[e] += ALPHA * (float)rv[e]; v1[e] += ALPHA * (float)rv[4 + e]; }
                    if (F32OUT) { *(f32x4*)(o32 + off) = v0; *(f32x4*)(o32 + off + 4) = v1; }
                    else *(u32x4*)(o16 + off) = pack8(v0, v1);
                }
            }
    }
};
template <bool F32OUT> struct EpiResLN {
    static constexpr bool FUSED_LN = true;
    const f16* res; f16* o16; float* o32; const float* g; const float* b; unsigned long long* xbuf; unsigned* cnt;
    __device__ __forceinline__ void fused(AccT& acc, const Unit& u, int wr, int wc, int fr, int fq, LAS unsigned char* lx, int tid) const {
        LAS f32x2* P = (LAS f32x2*)lx;
        LAS f32x2* Sx = (LAS f32x2*)(lx + 8192);
        LAS unsigned* flag = (LAS unsigned*)(lx + 8192 + 2048);
#pragma unroll
        for (int ai = 0; ai < 2; ++ai)
#pragma unroll
            for (int m = 0; m < 4; ++m) {
                const int row = EPI_ROW(u, ai, m); float s1 = 0.f, s2 = 0.f;
#pragma unroll
                for (int bj = 0; bj < 2; ++bj) {
                    const half8 rv = *(const half8*)(res + (size_t)row * DM + EPI_COL(u, bj));
#pragma unroll
                    for (int e = 0; e < 4; ++e) { acc[ai][bj][m][0][e] += ALPHA * (float)rv[e]; acc[ai][bj][m][1][e] += ALPHA * (float)rv[4 + e]; }
                    const f32x4 a0 = acc[ai][bj][m][0], a1 = acc[ai][bj][m][1];
                    s1 += ((a0[0] + a0[1]) + (a0[2] + a0[3])) + ((a1[0] + a1[1]) + (a1[2] + a1[3])); s2 += sumsq4(a0) + sumsq4(a1);
                }
                s1 += __shfl_xor(s1, 16); s1 += __shfl_xor(s1, 32); s2 += __shfl_xor(s2, 16); s2 += __shfl_xor(s2, 32);
                if (fq == 0) P[(ai * 128 + wr * 64 + m * 16 + fr) * 4 + wc] = (f32x2){s1, s2};
            }
        asm volatile("s_waitcnt lgkmcnt(0)" ::: "memory"); __builtin_amdgcn_s_barrier(); asm volatile("" ::: "memory");
        if (tid < 256) {
            const f32x2 a = P[tid * 4 + 0], b2 = P[tid * 4 + 1], c = P[tid * 4 + 2], d = P[tid * 4 + 3];
            const float S1 = (a.x + b2.x) + (c.x + d.x), S2 = (a.y + b2.y) + (c.y + d.y);
            __hip_atomic_store(xbuf + ((size_t)(u.pm * 256 + tid) * 4 + u.pn), ((unsigned long long)__float_as_uint(S2) << 32) | __float_as_uint(S1), __ATOMIC_RELAXED, __HIP_MEMORY_SCOPE_AGENT);
            asm volatile("s_waitcnt vmcnt(0)" ::: "memory");
            if ((tid & 63) == 0) __hip_atomic_fetch_add(cnt + 64 * u.pm, 1u, __ATOMIC_RELAXED, __HIP_MEMORY_SCOPE_AGENT);
        }
        if (tid < 64) {
            unsigned spins = 0;
            while ((unsigned)__builtin_amdgcn_readfirstlane(__hip_atomic_load(cnt + 64 * u.pm, __ATOMIC_RELAXED, __HIP_MEMORY_SCOPE_AGENT)) < 16u) { __builtin_amdgcn_s_sleep(2); if (++spins > (1u << 22)) break; }
            __builtin_amdgcn_fence(__ATOMIC_ACQUIRE, "agent");
            if (tid == 0) flag[0] = 1u;
        }
        asm volatile("s_waitcnt vmcnt(0) lgkmcnt(0)" ::: "memory"); __builtin_amdgcn_s_barrier(); asm volatile("" ::: "memory");
        if (tid < 256) {
            const unsigned long long* slot = xbuf + (size_t)(u.pm * 256 + tid) * 4; float S1 = 0.f, S2 = 0.f;
#pragma unroll
            for (int t = 0; t < 4; ++t) { const unsigned long long w = __hip_atomic_load(slot + t, __ATOMIC_RELAXED, __HIP_MEMORY_SCOPE_AGENT); S1 += __uint_as_float((unsigned)w); S2 += __uint_as_float((unsigned)(w >> 32)); }
            const float mean = S1 * (1.0f / DM), var = fmaxf(S2 * (1.0f / DM) - mean * mean, 0.f);
            Sx[tid] = (f32x2){mean, 1.0f / sqrtf(var + LN_EPS)};
        }
        asm volatile("s_waitcnt lgkmcnt(0)" ::: "memory"); __builtin_amdgcn_s_barrier(); asm volatile("" ::: "memory");
        f32x4 gv[2][2], bv[2][2];
#pragma unroll
        for (int bj = 0; bj < 2; ++bj)
#pragma unroll
            for (int n = 0; n < 2; ++n) { gv[bj][n] = *(const f32x4*)(g + EPI_COL(u, bj) + 4 * n); bv[bj][n] = *(const f32x4*)(b + EPI_COL(u, bj) + 4 * n); }
#pragma unroll
        for (int ai = 0; ai < 2; ++ai)
#pragma unroll
            for (int m = 0; m < 4; ++m) {
                const int row = EPI_ROW(u, ai, m); const f32x2 st = Sx[ai * 128 + wr * 64 + m * 16 + fr];
#pragma unroll
                for (int bj = 0; bj < 2; ++bj) {
                    const size_t off = (size_t)row * DM + EPI_COL(u, bj);
                    const f32x4 y0 = (acc[ai][bj][m][0] - st.x) * st.y * gv[bj][0] + bv[bj][0], y1 = (acc[ai][bj][m][1] - st.x) * st.y * gv[bj][1] + bv[bj][1];
                    if (F32OUT) { *(f32x4*)(o32 + off) = y0; *(f32x4*)(o32 + off + 4) = y1; }
                    else *(u32x4*)(o16 + off) = pack8(y0, y1);
                }
            }
    }
};
struct EpiGLU {
    static constexpr bool FUSED_LN = false;
    f16* H;
    __device__ __forceinline__ void operator()(const AccT& acc, const Unit& u, int wr, int wc, int fr, int fq) const {
#pragma unroll
        for (int ai = 0; ai < 2; ++ai)
#pragma unroll
            for (int m = 0; m < 4; ++m) {
                const int row = EPI_ROW(u, ai, m);
                f32x4 h0, h1;
#pragma unroll
                for (int e = 0; e < 4; ++e) { const float g0 = acc[ai][0][m][0][e], g1 = acc[ai][0][m][1][e];
                    h0[e] = g0 * sigmoidf_(g0) * acc[ai][1][m][0][e]; h1[e] = g1 * sigmoidf_(g1) * acc[ai][1][m][1][e]; }
                *(u32x4*)(H + (size_t)row * DFF + u.pn * 128 + wc * 32 + 8 * fq) = pack8(h0, h1);
            }
    }
};

#ifndef ATT_QREG
#define ATT_QREG 6
#endif
#ifndef ATT_SDEPTH
#define ATT_SDEPTH 1
#endif
namespace att {
constexpr int SHM_V = 64 * 128 * 2, SHM_K = 64 * 192 * 2, KRING = 3 * SHM_V, SHM_WS = 3 * SHM_V + 2 * SHM_K, SHM_Q = SHM_WS + 8 * 64 * 4, QREG = ATT_QREG, QLDS = 12 - QREG, SHM_TOTAL = 100352;
constexpr float THR2 = 8.f * 1.4426950408889634f;
#define KSWZ(row, colB) ((row) * 384 + ((colB) ^ (((row) & 7) << 4)))
#define SBAR() __builtin_amdgcn_sched_barrier(0)
__device__ __forceinline__ int crow(int r, int hi) { return (r & 3) + 8 * (r >> 2) + 4 * hi; }
constexpr float CQ = QSCALE;
constexpr float SH = 4.f;
constexpr float THRQ = 4.f / CQ;
constexpr int VT_TILE = 8192, K_TILE = 12288, VT_SLOT = 2 * VT_TILE, K_SLOT = 2 * K_TILE, KRING8 = 3 * VT_SLOT, WS8 = KRING8 + 2 * K_SLOT, SHM8 = WS8 + 8 * 64 * 4;
constexpr float THRL = 4.f;
template <bool FIRST>
__device__ __forceinline__ void partialSM(f32x16& p0, f32x16& p1, f32x16& negm, float& dl, float& alpha) {
    float pmax = p0[0];
#pragma unroll
    for (int r = 1; r < 16; ++r) pmax = fmaxf(pmax, p0[r]);
#pragma unroll
    for (int r = 0; r < 16; ++r) pmax = fmaxf(pmax, p1[r]);
    { auto rr = __builtin_amdgcn_permlane32_swap(__float_as_uint(pmax), __float_as_uint(pmax), false, false);
      pmax = fmaxf(__uint_as_float(rr[0]), __uint_as_float(rr[1])); }
    if (FIRST) {
        dl = 0.f; alpha = 1.f; const float d0_ = pmax - SH;
#pragma unroll
        for (int r = 0; r < 16; ++r) { p0[r] -= d0_; p1[r] -= d0_; negm[r] -= d0_; }
    } else {
        const bool keep = __all(pmax <= SH + THRL);
        dl = keep ? 0.f : fmaxf(pmax - SH, 0.f); alpha = __builtin_amdgcn_exp2f(-dl);
    }
#pragma unroll
    for (int r = 0; r < 16; ++r) p0[r] = __builtin_amdgcn_exp2f(p0[r]);
}
__device__ __forceinline__ void finishSM(f32x16& p0, f32x16& p1, v8i& pa) {
#pragma unroll
    for (int r = 0; r < 16; ++r) p1[r] = __builtin_amdgcn_exp2f(p1[r]);
#pragma unroll
    for (int w = 0; w < 4; ++w) { pa[w] = (int)pk4_fp8(p0[4 * w], p0[4 * w + 1], p0[4 * w + 2], p0[4 * w + 3]); pa[4 + w] = (int)pk4_fp8(p1[4 * w], p1[4 * w + 1], p1[4 * w + 2], p1[4 * w + 3]); }
}
#define MFMA8(A, B, C) __builtin_amdgcn_mfma_scale_f32_32x32x64_f8f6f4(A, B, C, 0, 0, 0, 0x7F7F7F7F, 0, 0x7F7F7F7F)
__device__ __forceinline__ v8i ld32(const LAS char* a0, const LAS char* a1) { const v4i x = *(const LAS v4i*)a0, y = *(const LAS v4i*)a1; return (v8i){x[0], x[1], x[2], x[3], y[0], y[1], y[2], y[3]}; }
#define MFMA8QK(A, B, C) __builtin_amdgcn_mfma_scale_f32_32x32x64_f8f6f4(A, B, C, 0, 0, 0, 0x7F7F7F7F, 0, 0x7C7C7C7C)
__device__ __forceinline__ void qkt(f32x16& p0, f32x16& p1, const LAS char* Ks, int ka0, int ka1, const v8i* qf, const f32x16& negm) {
#pragma unroll
    for (int st = 0; st < 3; ++st) {
        const v8i k0 = ld32(Ks + ka0 + 64 * st, Ks + ka1 + 64 * st), k1 = ld32(Ks + ka0 + 64 * st + 32 * 192, Ks + ka1 + 64 * st + 32 * 192);
        if (st == 0) { p0 = MFMA8QK(k0, qf[st], negm); p1 = MFMA8QK(k1, qf[st], negm); }
        else { p0 = MFMA8QK(k0, qf[st], p0); p1 = MFMA8QK(k1, qf[st], p1); } }
}
__device__ __forceinline__ void pv_d0(f32x16* o, const LAS char* Vs, int va0, int va1, v8i pa) {
#pragma unroll
    for (int d0 = 0; d0 < 4; ++d0) { const v8i vf = ld32(Vs + va0 + 2048 * d0, Vs + va1 + 2048 * d0); o[d0] = MFMA8(pa, vf, o[d0]); }
    const v8i ones = {0x38383838, 0x38383838, 0x38383838, 0x38383838, 0x38383838, 0x38383838, 0x38383838, 0x38383838};
    o[4] = MFMA8(pa, ones, o[4]);
}
__device__ __forceinline__ void attn_unit(const unsigned char* __restrict__ Qb, const unsigned char* __restrict__ Kh, const unsigned char* __restrict__ VTh, f16* __restrict__ Ob, int seq, LAS char* lds) {
    const int tid = otid(), wid = __builtin_amdgcn_readfirstlane(tid >> 6), lane = tid & 63, r32 = lane & 31, hi = lane >> 5;
    LAS float* ws = (LAS float*)(lds + WS8) + wid * 64; LAS float* li_l = ws; LAS float* al_l = ws + 32;
    f32x16 o[5] = {}; v8i qf[3]; f32x16 negm;
#pragma unroll
    for (int r = 0; r < 16; ++r) negm[r] = SH;
    const unsigned char* Qw = Qb + (long)(wid * 32 + r32) * LDQ + hi * 32;
#pragma unroll
    for (int st = 0; st < 3; ++st) { const v4i x = *(const v4i*)(Qw + 64 * st), y = *(const v4i*)(Qw + 64 * st + 16); qf[st] = (v8i){x[0], x[1], x[2], x[3], y[0], y[1], y[2], y[3]}; }
    const int sw = (r32 >> 2) & 3;
    const int ka0 = r32 * 192 + (((2 * hi) ^ sw) << 4), ka1 = r32 * 192 + (((2 * hi + 1) ^ sw) << 4);
    const int va0 = r32 * 64 + (((2 * hi) ^ sw) << 4), va1 = r32 * 64 + (((2 * hi + 1) ^ sw) << 4);
#define ISSUE(st) do { const int vo_ = ((st) % 3) * VT_SLOT, ko_ = KRING8 + ((st) & 1) * K_SLOT; const unsigned char* kp_ = Kh + (long)(st) * 128 * LDK; const unsigned char* vp_ = VTh + (long)(st) * (2 * 128 * 64); \
    const int ln_ = otid() & 63; \
    _Pragma("unroll") for (int i_ = 0; i_ < 5; ++i_) { const int c_ = wid + 8 * i_, t2_ = c_ / 20, cc_ = c_ % 20; unsigned go_; \
        if (cc_ < 8) go_ = (unsigned)(t2_ * (128 * 64) + cc_ * 1024 + ln_ * 16); \
        else { const int b_ = (cc_ - 8) * 1024 + ln_ * 16, row_ = b_ / 192, pc_ = (b_ % 192) >> 4, lc_ = pc_ ^ ((row_ >> 2) & 3); go_ = (unsigned)((t2_ * 64 + row_) * LDK + lc_ * 16); } \
        const unsigned char* g_ = (cc_ < 8 ? vp_ : kp_) + go_; \
        __builtin_amdgcn_global_load_lds((const unsigned*)g_, (LAS unsigned*)(lds + (cc_ < 8 ? vo_ + t2_ * VT_TILE + cc_ * 1024 : ko_ + t2_ * K_TILE + (cc_ - 8) * 1024)), 16, 0, 0); } } while (0)
#define SGB_QK() do { _Pragma("unroll") for (int g_ = 0; g_ < 3; ++g_) { __builtin_amdgcn_sched_group_barrier(0x100, 4, 0); __builtin_amdgcn_sched_group_barrier(0x8, 1, 0); __builtin_amdgcn_sched_group_barrier(0x2, 6, 0); \
        __builtin_amdgcn_sched_group_barrier(0x8, 1, 0); __builtin_amdgcn_sched_group_barrier(0x2, 6, 0); } } while (0)
#define SGB_PV() do { _Pragma("unroll") for (int g_ = 0; g_ < 4; ++g_) { __builtin_amdgcn_sched_group_barrier(0x100, 2, 0); __builtin_amdgcn_sched_group_barrier(0x8, 1, 0); __builtin_amdgcn_sched_group_barrier(0x2, 9, 0); } \
        __builtin_amdgcn_sched_group_barrier(0x8, 1, 0); __builtin_amdgcn_sched_group_barrier(0x2, 9, 0); } while (0)
#define WBAR() do { asm volatile("s_waitcnt vmcnt(0) lgkmcnt(0)" ::: "memory"); __builtin_amdgcn_s_barrier(); asm volatile("" ::: "memory"); } while (0)
#define FIX(a, dlt, P0, P1) do { if (__any((dlt) > 0.f)) { if (hi == 0) al_l[r32] = (a); asm volatile("s_waitcnt lgkmcnt(0)" ::: "memory"); \
    _Pragma("unroll") for (int d = 0; d < 5; ++d) _Pragma("unroll") for (int r = 0; r < 16; ++r) o[d][r] *= al_l[crow(r, hi)]; \
    _Pragma("unroll") for (int r = 0; r < 16; ++r) { P0[r] *= (a); P1[r] -= (dlt); negm[r] -= (dlt); } } } while (0)
#define KSL(tile) (lds + KRING8 + (((tile) >> 1) & 1) * K_SLOT + ((tile) & 1) * K_TILE)
#define VSL(tile) (lds + (((tile) >> 1) % 3) * VT_SLOT + ((tile) & 1) * VT_TILE)
    f32x16 pA0, pA1, pB0, pB1; float dlA, dlB, alA, alB; v8i pa; const int NT = seq / 64;
    const int NS = NT >> 1;
    WBAR();
    ISSUE(0);
    WBAR();
    if (1 < NS) ISSUE(1);
    qkt(pA0, pA1, KSL(0), ka0, ka1, qf, negm); partialSM<true>(pA0, pA1, negm, dlA, alA);
    for (int j = 1; j + 1 < NT; j += 2) {
        SBAR(); qkt(pB0, pB1, KSL(j), ka0, ka1, qf, negm);
        finishSM(pA0, pA1, pa); SBAR();
        pv_d0(o, VSL(j - 1), va0, va1, pa); partialSM<false>(pB0, pB1, negm, dlB, alB); SGB_PV();
        WBAR();
        { const int J = (j - 1) >> 1; if (J + 2 < NS) ISSUE(J + 2); }
        FIX(alB, dlB, pB0, pB1);
        SBAR(); qkt(pA0, pA1, KSL(j + 1), ka0, ka1, qf, negm);
        finishSM(pB0, pB1, pa); SBAR();
        pv_d0(o, VSL(j), va0, va1, pa); partialSM<false>(pA0, pA1, negm, dlA, alA); SGB_PV(); SBAR();
        FIX(alA, dlA, pA0, pA1);
    }
    SBAR(); qkt(pB0, pB1, KSL(NT - 1), ka0, ka1, qf, negm);
    finishSM(pA0, pA1, pa); SBAR();
    pv_d0(o, VSL(NT - 2), va0, va1, pa); partialSM<false>(pB0, pB1, negm, dlB, alB);
    FIX(alB, dlB, pB0, pB1);
    finishSM(pB0, pB1, pa); SBAR();
    pv_d0(o, VSL(NT - 1), va0, va1, pa);
    float rli[16];
#pragma unroll
    for (int r = 0; r < 16; ++r) rli[r] = __builtin_amdgcn_rcpf(o[4][r]);
    f16* Ow = Ob + (long)(wid * 32) * LDC;
#pragma unroll
    for (int r = 0; r < 16; ++r) { const int orow = crow(r, hi);
#pragma unroll
        for (int d0 = 0; d0 < 4; ++d0) Ow[(long)orow * LDC + d0 * 32 + r32] = (f16)(o[d0][r] * rli[r]); }
#undef ISSUE
#undef WBAR
#undef FIX
#undef SGB_QK
#undef SGB_PV
#undef KSL
#undef VSL
}
}

struct TrDesc { const float* src; const float* src2; const float* rs; f16* dst; int ld_src, ld_dst, k0, n0, mode; };
__device__ __forceinline__ void tr_load(const TrDesc& d, int tid, float (&v)[8]) {
    const int nn = tid & 63, np = d.n0 + nn; int col = np; const float* s = d.src;
    if (d.mode == 1) { if (np >= 1216) col = -1; else if (np >= 1152) { const int i = np - 1152; col = 1152 + (i >> 1) + 32 * (i & 1); } }
    else if (d.mode == 2) { const int h = np / 192, dd = np % 192; if (dd >= 128) { const int i = dd - 128; col = 192 * h + 128 + (i >> 1) + 32 * (i & 1); } }
    else if (d.mode == 3) { col = (np >> 8) * 128 + (np & 127); if ((np >> 7) & 1) s = d.src2; }
#pragma unroll
    for (int i = 0; i < 8; ++i) { const int kk = (tid >> 6) + 8 * i; float x = 0.f;
        if (col >= 0) { x = s[(size_t)(d.k0 + kk) * d.ld_src + col]; if (d.rs) x *= d.rs[d.k0 + kk]; if (d.mode == 2) x *= QSCALE * 8.0f; }
        v[i] = x; }
}
struct TrPtrs { const float* a; const float* b; const float* c; const float* d; const float* ga; const float* gb; f16* o0; f16* o1; f16* o2; f16* o3; };
template <int KIND> __device__ __forceinline__ TrDesc tr_desc(const TrPtrs& P, int it) {
    if (KIND == 0) {
        if (it < 320) return TrDesc{P.a, nullptr, nullptr, P.o0, 1216, DM, (it & 15) * 64, (it >> 4) * 64, 1};
        if (it < 368) { const int j = it - 320; return TrDesc{P.b, nullptr, P.ga, P.o1, 768, 256, (j & 3) * 64, (j >> 2) * 64, 2}; }
        if (it < 400) { const int j = it - 368; return TrDesc{P.c, nullptr, P.gb, P.o2, 1024, 128, (j & 1) * 64, (j >> 1) * 64, 0}; }
        const int j = it - 400; return TrDesc{P.d, nullptr, nullptr, P.o3, DM, DM, 512 + (j & 7) * 64, (j >> 3) * 64, 0};
    } else {
        if (it < 1408) return TrDesc{P.a, P.b, nullptr, P.o0, DFF, DM, (it & 15) * 64, (it >> 4) * 64, 3};
        const int j = it - 1408; return TrDesc{P.c, nullptr, nullptr, P.o1, DM, DFF, (j % 44) * 64, (j / 44) * 64, 0};
    }
}
template <int KIND>
__device__ __forceinline__ void tr_run(int first, int count, int stride, LAS float* scr, const TrPtrs P) {
    const int tid = otid();
    float v[8]; TrDesc d = tr_desc<KIND>(P, first < count ? first : 0); if (first < count) tr_load(d, tid, v); int buf = 0;
#pragma unroll 1
    for (int it = first; it < count; it += stride) {
        LAS float* sb = scr + buf * (64 * 65);
#pragma unroll
        for (int i = 0; i < 8; ++i) sb[((tid >> 6) + 8 * i) * 65 + (tid & 63)] = v[i];
        const TrDesc dc = d;
        if (it + stride < count) { d = tr_desc<KIND>(P, it + stride); tr_load(d, tid, v); }
        __syncthreads();
        { const int nn = tid >> 3, c8 = tid & 7; const LAS float* sp = sb + (c8 * 8) * 65 + nn;
          u32x4 w; w.x = cvtpk(sp[0], sp[65]); w.y = cvtpk(sp[2 * 65], sp[3 * 65]); w.z = cvtpk(sp[4 * 65], sp[5 * 65]); w.w = cvtpk(sp[6 * 65], sp[7 * 65]);
          *(u32x4*)(dc.dst + (size_t)(dc.n0 + nn) * dc.ld_dst + dc.k0 + c8 * 8) = w; }
        buf ^= 1;
    }
    __syncthreads();
}
__device__ __forceinline__ void conv_weights_A(const Params& p, int l, LAS float* scr) {
    unsigned char* ws = p.ws; const int G = ogd(), bx = obx();
    f16* WinT = (f16*)(ws + WS_WIN); f16* WuqT = (f16*)(ws + WS_WUQ); f16* WukvT = (f16*)(ws + WS_WUKV); f16* WoutT = (f16*)(ws + WS_WOUT);
    const float* w_in = p.in[I_WIN] + (size_t)l * DM * 1216; const float* w_uq = p.in[I_WUQ] + (size_t)l * 256 * 768; const float* w_ukv = p.in[I_WUKV] + (size_t)l * 128 * 1024;
    const float* w_out = p.in[I_WOUT] + (size_t)l * DM * DM; const float* g_q = p.in[I_GQ] + l * 256; const float* g_kv = p.in[I_GKV] + l * 128;
    const float* w_pw = p.in[I_WPW] + (size_t)l * 256 * 256; const float* w_pool = p.in[I_WPOOL] + (size_t)l * 4 * 64 * 64; const float* psc = p.in[I_PSC] + l * 256;
    tr_run<0>(bx, 528, G, scr, TrPtrs{w_in, w_uq, w_ukv, w_out, g_q, g_kv, WinT, WuqT, WukvT, WoutT});
    for (int idx = bx * 512 + otid(); idx < 128 * 1024; idx += G * 512) {
        const int k0 = (idx >> 10) * 4, n = idx & 1023; float a0 = 0.f, a1 = 0.f, a2 = 0.f, a3 = 0.f;
        if (k0 < 256) { const float* wp = w_pw + k0 * 256; const float* wo = w_out + n;
#pragma unroll 32
            for (int j = 0; j < 256; ++j) { const float bv = wo[(size_t)j * DM]; a0 += wp[j] * bv; a1 += wp[256 + j] * bv; a2 += wp[512 + j] * bv; a3 += wp[768 + j] * bv; } }
        else { const int g = (k0 - 256) >> 6, c = (k0 - 256) & 63; const float* wp = w_pool + (g * 64 + c) * 64; const float* sc = psc + 64 * g; const float* wo = w_out + (size_t)(256 + 64 * g) * DM + n;
#pragma unroll 32
               for (int j = 0; j < 64; ++j) { const float bv = sc[j] * wo[(size_t)j * DM]; a0 += wp[j] * bv; a1 += wp[64 + j] * bv; a2 += wp[128 + j] * bv; a3 += wp[192 + j] * bv; } }
        u32x2 w2; w2.x = cvtpk(a0, a1); w2.y = cvtpk(a2, a3);
        *(u32x2*)(WoutT + (size_t)n * DM + k0) = w2;
    }
}
__device__ __forceinline__ void conv_weights_F(const Params& p, int l, LAS float* scr) {
    unsigned char* ws = p.ws; const int G = ogd(), bx = obx();
    f16* WguT = (f16*)(ws + WS_WGU); f16* WdT = (f16*)(ws + WS_WD);
    const float* w_g = p.in[I_WG] + (size_t)l * DM * DFF; const float* w_u = p.in[I_WU] + (size_t)l * DM * DFF; const float* w_d = p.in[I_WD] + (size_t)l * DFF * DM;
    tr_run<1>(bx, 2112, G, scr, TrPtrs{w_g, w_u, w_d, nullptr, nullptr, nullptr, WguT, WdT, nullptr, nullptr});
}
__device__ __forceinline__ void sincos_pi(double r, float& s, float& c) {
    const double h = 0.5 * r, h2 = h * h;
    double sh = 1.0 / 355687428096000.0; sh = sh * h2 - 1.0 / 1307674368000.0; sh = sh * h2 + 1.0 / 6227020800.0; sh = sh * h2 - 1.0 / 39916800.0; sh = sh * h2 + 1.0 / 362880.0;
    sh = sh * h2 - 1.0 / 5040.0; sh = sh * h2 + 1.0 / 120.0; sh = sh * h2 - 1.0 / 6.0; sh = sh * h2 + 1.0; sh *= h;
    double ch = -1.0 / 6402373705728000.0; ch = ch * h2 + 1.0 / 20922789888000.0; ch = ch * h2 - 1.0 / 87178291200.0; ch = ch * h2 + 1.0 / 479001600.0; ch = ch * h2 - 1.0 / 3628800.0;
    ch = ch * h2 + 1.0 / 40320.0; ch = ch * h2 - 1.0 / 720.0; ch = ch * h2 + 1.0 / 24.0; ch = ch * h2 - 0.5; ch = ch * h2 + 1.0;
    s = (float)(2.0 * sh * ch); c = (float)(1.0 - 2.0 * sh * sh);
}
__device__ __forceinline__ void prologue(const Params& p, LAS float* scr) {
    const int G = gridDim.x, bx = blockIdx.x, tid = otid(); const long gt = (long)bx * 512 + tid, gs = (long)G * 512;
    f16* XH = (f16*)((unsigned char*)p.out + DO_XH);
    for (long i = gt; i < (long)T * DM / 8; i += gs) {
        const float* src = (i < (long)TP * DM / 8) ? p.in[I_XP] + i * 8 : p.in[I_XS] + (i * 8 - (long)TP * DM);
        const f32x4 a = *(const f32x4*)src, b = *(const f32x4*)(src + 4);
        *(u32x4*)(XH + i * 8) = pack8(a, b);
    }
    float* ssq = (float*)(p.ws + WS_SSQ_Q);
    for (long i = gt; i < 2 * T; i += gs) ssq[i] = 0.f;
    float* cosT = (float*)(p.ws + WS_COS); float* sinT = (float*)(p.ws + WS_SIN);
    for (long i = gt; i < (long)TP * 32; i += gs) {
        const int pos = (int)(i >> 5), j = (int)(i & 31);
        const float ang = (float)pos * p.invf[j];
        const double a = (double)ang, k = rint(a * 0.15915494309189535), r = fma(-k, 6.283185307179586, a) - k * 2.4492935982947064e-16;
        float s, c; sincos_pi(r, s, c); cosT[i] = c; sinT[i] = s;
    }
}

__device__ __forceinline__ void convpool_phase(const Params& p, int l, LAS float* hb) {
    const int G = ogd(), bx = obx(), tid = otid(), wid = tid >> 6, lane = tid & 63;
    LAS float* ob = hb + 62 * 256;
    const f16* U = (const f16*)(p.ws + WS_U); f16* CAT = (f16*)(p.ws + WS_CAT); unsigned char* Kb = p.ws + WS_K;
    const float* cosT = (const float*)(p.ws + WS_COS); const float* sinT = (const float*)(p.ws + WS_SIN);
    const float* w_dw = p.in[I_WDW] + (size_t)l * 31 * 256; const float* b_dw = p.in[I_BDW] + l * 256;
    const float* g_cn = p.in[I_GCN] + l * 256; const float* b_cn = p.in[I_BCN] + l * 256;
    const int c = tid & 255, half = tid >> 8;
    float w[31];
#pragma unroll
    for (int k = 0; k < 31; ++k) w[k] = w_dw[k * 256 + c];
    const float bias = b_dw[c];
    const f32x4 gcn = *(const f32x4*)(g_cn + lane * 4), bcn = *(const f32x4*)(b_cn + lane * 4);
    LAS float* pb = ob + 32 * 256;
    const int g = c >> 6, left = 1 << g, wlen = 2 << g;
#pragma unroll 1
    for (int item = bx; item < T / 32; item += G) {
        const int t0 = item * 32; const int s0 = t0 < TP ? 0 : (TP + ((t0 - TP) & ~4095)), s1 = t0 < TP ? TP : s0 + 4096;
        half8 pv[3], av[4], gv[4];
#pragma unroll
        for (int i = 0; i < 3; ++i) { const int ci = tid + 512 * i, rr = ci >> 5, c8 = (ci & 31) * 8, t = t0 - 8 + rr; pv[i] = half8{};
            if (ci < 47 * 32 && t >= s0 && t < s1) pv[i] = *(const half8*)(U + (size_t)t * LDU + 512 + c8); }
#pragma unroll
        for (int i = 0; i < 4; ++i) { const int ci = tid + 512 * i, rr = ci >> 5, c8 = (ci & 31) * 8, t = t0 - 15 + rr; av[i] = half8{}; gv[i] = half8{};
            if (ci < 62 * 32 && t >= s0 && t < s1) { av[i] = *(const half8*)(U + (size_t)t * LDU + c8); gv[i] = *(const half8*)(U + (size_t)t * LDU + 256 + c8); } }
        { const int tt = tid >> 4, q4 = (tid & 15) * 4, t = t0 + tt, pos = posof(t);
          const half4 x = *(const half4*)(U + (size_t)t * LDU + 1152 + q4);
          const f32x2 c2 = *(const f32x2*)(cosT + pos * 32 + (q4 >> 1)), s2 = *(const f32x2*)(sinT + pos * 32 + (q4 >> 1));
          const float a0 = (float)x[0], a1 = (float)x[1], a2 = (float)x[2], a3 = (float)x[3];
          const unsigned w2 = pk4_fp8(a0 * c2[0] - a1 * s2[0], a0 * s2[0] + a1 * c2[0], a2 * c2[1] - a3 * s2[1], a2 * s2[1] + a3 * c2[1]);
          unsigned char* kp = Kb + (size_t)t * LDK + 128 + q4;
#pragma unroll
          for (int h = 0; h < 4; ++h) *(unsigned*)(kp + 192 * h) = w2; }
#pragma unroll
        for (int i = 0; i < 3; ++i) { const int ci = tid + 512 * i; if (ci < 47 * 32) { LAS float* d = pb + (ci >> 5) * 256 + (ci & 31) * 8;
            *(LAS f32x4*)d = (f32x4){(float)pv[i][0], (float)pv[i][1], (float)pv[i][2], (float)pv[i][3]}; *(LAS f32x4*)(d + 4) = (f32x4){(float)pv[i][4], (float)pv[i][5], (float)pv[i][6], (float)pv[i][7]}; } }
#pragma unroll
        for (int i = 0; i < 4; ++i) { const int ci = tid + 512 * i; if (ci < 62 * 32) { LAS float* d = hb + (ci >> 5) * 256 + (ci & 31) * 8; f32x4 h0, h1;
#pragma unroll
            for (int e = 0; e < 4; ++e) { h0[e] = (float)av[i][e] * sigmoidf_((float)gv[i][e]); h1[e] = (float)av[i][4 + e] * sigmoidf_((float)gv[i][4 + e]); }
            *(LAS f32x4*)d = h0; *(LAS f32x4*)(d + 4) = h1; } }
        __syncthreads();
        { const int tt0 = half * 16; float sum = 0.f;
#pragma unroll
          for (int k = 0; k < 16; ++k) if (k < wlen) sum += pb[(tt0 + 8 - left + k) * 256 + c];
#pragma unroll 4
          for (int q = 0; q < 16; ++q) { const int tt = tt0 + q, t = t0 + tt;
              const int lo = max(t - left, s0), hi = min(t + wlen - left, s1);
              const float d = sum / (float)(hi - lo) - pb[(tt + 8) * 256 + c];
              CAT[(size_t)t * LDC + 256 + c] = (f16)d;
              sum += pb[(tt + 8 - left + wlen) * 256 + c] - pb[(tt + 8 - left) * 256 + c]; } }
#pragma unroll 1
        for (int qg = 0; qg < 2; ++qg) { const int tb = half * 16 + qg * 8;
            float win[38];
#pragma unroll
            for (int i = 0; i < 38; ++i) win[i] = hb[(tb + i) * 256 + c];
#pragma unroll
            for (int q = 0; q < 8; ++q) { float a = bias;
#pragma unroll
                for (int k = 0; k < 31; ++k) a += w[k] * win[q + k];
                ob[(tb + q) * 256 + c] = a; } }
        __syncthreads();
#pragma unroll
        for (int q = 0; q < 4; ++q) { const int tt = wid * 4 + q; f32x4 v = *(const LAS f32x4*)(ob + tt * 256 + lane * 4);
            const float mean = wave_sum((v[0] + v[1]) + (v[2] + v[3])) * (1.0f / 256.0f);
            v = v - mean;
            const float var = wave_sum((v[0] * v[0] + v[1] * v[1]) + (v[2] * v[2] + v[3] * v[3])) * (1.0f / 256.0f);
            const float rstd = 1.0f / sqrtf(var + LN_EPS);
            f32x4 y = v * rstd * gcn + bcn;
#pragma unroll
            for (int e = 0; e < 4; ++e) y[e] = y[e] * sigmoidf_(y[e]);
            u32x2 o2; o2.x = cvtpk(y[0], y[1]); o2.y = cvtpk(y[2], y[3]);
            *(u32x2*)(CAT + (size_t)(t0 + tt) * LDC + lane * 4) = o2; }
        __syncthreads();
    }
}

__device__ __forceinline__ void ln_pass_f16(f16* buf, const float* g, const float* b) {
    const int tid_ = otid(), lane = tid_ & 63, wv = obx() * 8 + (tid_ >> 6), nw = ogd() * 8;
    const f32x4 g0 = *(const f32x4*)(g + lane * 8), g1 = *(const f32x4*)(g + lane * 8 + 4), g2 = *(const f32x4*)(g + 512 + lane * 8), g3 = *(const f32x4*)(g + 512 + lane * 8 + 4);
    const f32x4 b0 = *(const f32x4*)(b + lane * 8), b1 = *(const f32x4*)(b + lane * 8 + 4), b2 = *(const f32x4*)(b + 512 + lane * 8), b3 = *(const f32x4*)(b + 512 + lane * 8 + 4);
#pragma unroll 1
    for (int row = wv; row < T; row += 4 * nw) {
        half8 x0[4], x1[4];
#pragma unroll
        for (int j = 0; j < 4; ++j) { const int r = row + j * nw; x0[j] = half8{}; x1[j] = half8{};
            if (r < T) { const f16* rp = buf + (size_t)r * DM + lane * 8; x0[j] = *(const half8*)rp; x1[j] = *(const half8*)(rp + 512); } }
#pragma unroll
        for (int j = 0; j < 4; ++j) { const int r = row + j * nw; if (r >= T) break;
            f32x4 v0, v1, v2, v3;
#pragma unroll
            for (int e = 0; e < 4; ++e) { v0[e] = (float)x0[j][e]; v1[e] = (float)x0[j][4 + e]; v2[e] = (float)x1[j][e]; v3[e] = (float)x1[j][4 + e]; }
            f32x4 s4 = (v0 + v1) + (v2 + v3);
            const float mean = wave_sum((s4[0] + s4[1]) + (s4[2] + s4[3])) * (1.0f / DM);
            v0 = v0 - mean; v1 = v1 - mean; v2 = v2 - mean; v3 = v3 - mean;
            f32x4 q4 = (v0 * v0 + v1 * v1) + (v2 * v2 + v3 * v3);
            const float rstd = 1.0f / sqrtf(wave_sum((q4[0] + q4[1]) + (q4[2] + q4[3])) * (1.0f / DM) + LN_EPS);
            f16* rp = buf + (size_t)r * DM + lane * 8;
            *(u32x4*)rp = pack8(v0 * rstd * g0 + b0, v1 * rstd * g1 + b1);
            *(u32x4*)(rp + 512) = pack8(v2 * rstd * g2 + b2, v3 * rstd * g3 + b3);
        }
    }
}
__device__ __forceinline__ void ln_pass_f32(float* buf, const float* g, const float* b) {
    const int tid_ = otid(), lane = tid_ & 63, wv = obx() * 8 + (tid_ >> 6), nw = ogd() * 8;
    for (int row = wv; row < T; row += nw) {
        float* rp = buf + (size_t)row * DM + lane * 4;
        f32x4 v[4]; f32x4 s4 = {0.f, 0.f, 0.f, 0.f};
#pragma unroll
        for (int j = 0; j < 4; ++j) { v[j] = *(const f32x4*)(rp + 256 * j); s4 = s4 + v[j]; }
        const float mean = wave_sum((s4[0] + s4[1]) + (s4[2] + s4[3])) * (1.0f / DM);
        f32x4 q4 = {0.f, 0.f, 0.f, 0.f};
#pragma unroll
        for (int j = 0; j < 4; ++j) { v[j] = v[j] - mean; q4 = q4 + v[j] * v[j]; }
        const float rstd = 1.0f / sqrtf(wave_sum((q4[0] + q4[1]) + (q4[2] + q4[3])) * (1.0f / DM) + LN_EPS);
#pragma unroll
        for (int j = 0; j < 4; ++j) { const f32x4 gg = *(const f32x4*)(g + lane * 4 + 256 * j), bb = *(const f32x4*)(b + lane * 4 + 256 * j);
            *(f32x4*)(rp + 256 * j) = v[j] * rstd * gg + bb; }
    }
}

#define XB_TMO      128
#define XB_XCNT(j)  (256  + 64 * (j))
#define XB_XSUB(j)  (1280 + 64 * (j))
#define XB_XGEN(j)  (2304 + 64 * (j))
#define XB_TOP      3328
#define XB_TOPGEN   3392
#define XCD_BAR_WORDS 3456
#define XB_SPIN_CAP (1u << 18)

__device__ __forceinline__ unsigned xb_ld(unsigned* p)              { return __hip_atomic_load(p, __ATOMIC_RELAXED, __HIP_MEMORY_SCOPE_AGENT); }
__device__ __forceinline__ unsigned xb_add(unsigned* p, unsigned v) { return __hip_atomic_fetch_add(p, v, __ATOMIC_RELAXED, __HIP_MEMORY_SCOPE_AGENT); }
__device__ __forceinline__ unsigned xb_xcc_id() { return (unsigned)__builtin_amdgcn_s_getreg((3 << 11) | 20) & 0xFu; }
#define XB_SPIN(cond, bar) do { unsigned _sp = 0; while (cond) { __builtin_amdgcn_s_sleep(1); \
    if ((++_sp & 255u) == 0u) { if (xb_ld(&(bar)[XB_TMO])) break; if (_sp > XB_SPIN_CAP) { atomicAdd(&(bar)[XB_TMO], 1u); break; } } } } while (0)

struct XcdBarrier {
    unsigned* bar; unsigned x;
    volatile LAS unsigned* st;
};

__device__ __forceinline__ XcdBarrier xcd_barrier_post(unsigned* bar, volatile LAS unsigned* st) {
    XcdBarrier b; b.bar = bar; b.x = xb_xcc_id(); b.st = st;
    if (threadIdx.x == 0) (void)xb_add(&bar[XB_XCNT(b.x)], 1u);
    return b;
}
__device__ __forceinline__ void xcd_barrier_complete(unsigned* bar, unsigned x, unsigned& nloc, unsigned& nx) {
    const unsigned G = gridDim.x * gridDim.y * gridDim.z;
    unsigned sum, cnt, mine, sp = 0u;
    for (;;) {
        sum = 0u; cnt = 0u; mine = 0u;
#pragma unroll
        for (unsigned j = 0; j < 16; ++j) { const unsigned c = xb_ld(&bar[XB_XCNT(j)]); sum += c; cnt += (c > 0u) ? 1u : 0u; mine = (j == x) ? c : mine; }
        if (sum == G) break;
        __builtin_amdgcn_s_sleep(1);
        if ((++sp & 255u) == 0u) { if (xb_ld(&bar[XB_TMO])) break; if (sp > XB_SPIN_CAP) { atomicAdd(&bar[XB_TMO], 1u); break; } }
    }
    nloc = mine > 0u ? mine : 1u; nx = cnt > 0u ? cnt : 1u;
}

__device__ __forceinline__ void xcd_barrier(const XcdBarrier& b) {
    asm volatile("s_waitcnt vmcnt(0)" ::: "memory");
    __syncthreads();
    if (threadIdx.x == 0) {
        unsigned* bar = b.bar;
        __builtin_amdgcn_s_waitcnt(0);
        unsigned nloc = b.st[0], nx = b.st[1];
        if (nloc == 0u) { xcd_barrier_complete(bar, b.x, nloc, nx); b.st[0] = nloc; b.st[1] = nx; }
        const unsigned old = xb_add(&bar[XB_XSUB(b.x)], 1u);
        const unsigned gen = old / nloc;
        if (old + 1u == (gen + 1u) * nloc) {
            __builtin_amdgcn_fence(__ATOMIC_RELEASE, "agent");
            asm volatile("s_waitcnt vmcnt(0)" ::: "memory");
            const unsigned og = xb_add(&bar[XB_TOP], 1u);
            const unsigned tg = og / nx;
            if (og + 1u == (tg + 1u) * nx) xb_add(&bar[XB_TOPGEN], 1u);
            else XB_SPIN(xb_ld(&bar[XB_TOPGEN]) == tg, bar);
            __builtin_amdgcn_fence(__ATOMIC_ACQUIRE, "agent");
            xb_add(&bar[XB_XGEN(b.x)], 1u);
            asm volatile("s_waitcnt vmcnt(0)" ::: "memory");
        } else {
            XB_SPIN(xb_ld(&bar[XB_XGEN(b.x)]) == gen, bar);
            __builtin_amdgcn_fence(__ATOMIC_ACQUIRE, "agent");
            asm volatile("s_waitcnt vmcnt(0)" ::: "memory");
        }
    }
    __syncthreads();
}


constexpr int CONV_LDS = (62 + 32 + 47) * 256 * 4 + 1024, GEMM_LDS = pg8::STAGE_BYTES + 12288;
constexpr int LDS_BYTES0 = att::SHM_TOTAL > GEMM_LDS ? att::SHM_TOTAL : GEMM_LDS, LDS_BYTES = LDS_BYTES0 > CONV_LDS ? LDS_BYTES0 : CONV_LDS;
static_assert(att::SHM_TOTAL <= LDS_BYTES && (62 + 32 + 47) * 256 * 4 <= LDS_BYTES, "LDS");
constexpr int NSUB = 8, N_PHASES = 1 + NSUB * NL;
#ifndef PHB
#define PHB 7
#endif
#ifndef PHM
#define PHM 511
#endif

__global__ void __launch_bounds__(512, 2) mega_fwd(Params p) {
    extern __shared__ __attribute__((aligned(16))) unsigned char lds_raw[];
    LAS unsigned char* lds = (LAS unsigned char*)lds_raw;
    cg::grid_group grid = cg::this_grid();
    volatile LAS unsigned* xst = (volatile LAS unsigned*)(lds + LDS_BYTES);
    if (threadIdx.x < 4) xst[threadIdx.x] = 0u;
    __syncthreads();
    unsigned* barw = (unsigned*)(p.ws + WS_BAR);
    if (p.ph_lo == 0) {
        if (blockIdx.x == 0) for (int i = threadIdx.x; i < XCD_BAR_WORDS; i += 512) barw[i] = 0u;
        if (PHM & 1) prologue(p, (LAS float*)lds);
        if (p.ph_hi > 1) grid.sync(); }
    XcdBarrier xb; xb.bar = barw; xb.x = 0; xb.st = xst;
    if (p.ph_hi - p.ph_lo > 1) xb = xcd_barrier_post(barw, xst);
    for (int ph_ = p.ph_lo; ph_ < p.ph_hi; ++ph_) {
        int ph = __builtin_amdgcn_readfirstlane(ph_); asm volatile("" : "+s"(ph));
        int sub = -1; const int G = ogd(), bx = obx();
        Params q;
#pragma unroll
        for (int i = 0; i < 22; ++i) { const float* t = p.in[i]; asm volatile("" : "+s"(t)); q.in[i] = t; }
        { float* t = p.out; asm volatile("" : "+s"(t)); q.out = t; } { unsigned char* t = p.ws; asm volatile("" : "+s"(t)); q.ws = t; }
        unsigned char* ws = q.ws; unsigned char* outb = (unsigned char*)q.out;
        f16* XH = (f16*)(outb + DO_XH); unsigned char* Qb = outb + DO_Q;
        f16* U = (f16*)(ws + WS_U); f16* X1H = (f16*)(ws + WS_U); f16* Hb = (f16*)(ws + WS_H);
        unsigned char* Kb = ws + WS_K; unsigned char* Vb = ws + WS_V; f16* CAT = (f16*)(ws + WS_CAT);
        float* ssq_q = (float*)(ws + WS_SSQ_Q); float* ssq_kv = (float*)(ws + WS_SSQ_KV);
        const float* cosT = (const float*)(ws + WS_COS); const float* sinT = (const float*)(ws + WS_SIN);
        const f16* WinT = (const f16*)(ws + WS_WIN); const f16* WuqT = (const f16*)(ws + WS_WUQ); const f16* WukvT = (const f16*)(ws + WS_WUKV); const f16* WoutT = (const f16*)(ws + WS_WOUT);
        const f16* WguT = (const f16*)(ws + WS_WGU); const f16* WdT = (const f16*)(ws + WS_WD);
        if (ph == 0) { conv_weights_A(q, 0, (LAS float*)lds); conv_weights_F(q, 0, (LAS float*)lds); }
        else {
            const int l = (ph - 1) / NSUB; sub = (ph - 1) % NSUB;
            unsigned* cnt = (unsigned*)(ws + WS_CNT); unsigned long long* xbuf = (unsigned long long*)(ws + WS_XBUF);
            if (sub == 0 && (PHM & 2)) {
                for (int i = bx * 512 + otid(); i < 2 * 128 * 64; i += G * 512) cnt[i] = 0u;
                if (l > 0) conv_weights_F(q, l, (LAS float*)lds);
                pg8::Gemm g{XH, WinT, DM, DM, T, DINP, DM}; pg8::StaticOrder S; S.init(T, DINP, G, bx);
                EpiA E{U, ssq_q, ssq_kv};
                pg8::gemm_phase<EpiA>(lds, g, S, E);
            } else if (sub == 1 && (PHM & 4) && (PHB & 1)) {
                { pg8::Gemm g{U + 768, WuqT, LDU, 256, T, 768, 256}; pg8::StaticOrder S; S.init(T, 768, G, bx);
                  EpiQ E{Qb, ssq_q, cosT, sinT}; pg8::gemm_phase<EpiQ>(lds, g, S, E); }
            } else if (sub == 2 && (PHM & 4) && (PHB & 2)) {
                { pg8::Gemm g{U + 1024, WukvT, LDU, 128, T, 1024, 128}; pg8::StaticOrder S; S.init(T, 1024, G, bx);
                  EpiKV E{Kb, Vb, ssq_kv}; pg8::gemm_phase<EpiKV>(lds, g, S, E); }
            } else if (sub == 3 && (PHM & 4) && (PHB & 4)) {
                convpool_phase(q, l, (LAS float*)lds);
            } else if (sub == 4 && (PHM & 8)) {
                for (int uidx = bx; uidx < 512; uidx += G) {
                    const int v = uidx & 255, xcd = v & 7, slot = v >> 3;
                    int row0, h, seq0, seqlen;
                    if (uidx < 256) { h = xcd >> 1; const int qb = (xcd & 1) * 32 + slot; seq0 = 0; seqlen = TP; row0 = qb * 256; }
                    else { const int sq = xcd >> 1; h = 2 * (xcd & 1) + (slot >> 4); const int qb = slot & 15; seq0 = TP + sq * 4096; seqlen = 4096; row0 = seq0 + qb * 256; }
                    att::attn_unit(Qb + (size_t)row0 * LDQ + 192 * h, Kb + (size_t)seq0 * LDK + 192 * h, Vb + ((size_t)h * (T / 64) + (seq0 >> 6)) * (128 * 64),
                                      CAT + (size_t)row0 * LDC + 512 + 128 * h, seqlen, (LAS char*)lds);
                }
            } else if (sub == 5 && (PHM & 16)) {
                pg8::Gemm g{CAT, WoutT, DM, DM, T, DM, DM}; pg8::StaticOrder S; S.init(T, DM, G, bx); S.panel = (G != 256);
                EpiResLN<false> E{XH, X1H, nullptr, q.in[I_LN1G] + l * DM, q.in[I_LN1B] + l * DM, xbuf, cnt}; pg8::gemm_phase<EpiResLN<false>>(lds, g, S, E);
            } else if (sub == 6 && (PHM & 64)) {
                for (long i = (long)bx * 512 + otid(); i < 2 * T; i += (long)G * 512) ssq_q[i] = 0.f;
                if (l + 1 < NL) conv_weights_A(q, l + 1, (LAS float*)lds);
                pg8::Gemm g{X1H, WguT, DM, DM, T, 2 * DFF, DM}; pg8::StaticOrder S; S.init(T, 2 * DFF, G, bx);
                EpiGLU E{Hb}; pg8::gemm_phase<EpiGLU>(lds, g, S, E);
            } else if (sub == 7 && (PHM & 128)) {
                pg8::Gemm g{Hb, WdT, DFF, DFF, T, DM, DFF}; pg8::StaticOrder S; S.init(T, DM, G, bx); S.panel = (G != 256);
                if (l == NL - 1) { EpiResLN<true> E{X1H, nullptr, q.out, q.in[I_LN2G] + l * DM, q.in[I_LN2B] + l * DM, xbuf, cnt + 128 * 64}; pg8::gemm_phase<EpiResLN<true>>(lds, g, S, E); }
                else { EpiResLN<false> E{X1H, XH, nullptr, q.in[I_LN2G] + l * DM, q.in[I_LN2B] + l * DM, xbuf, cnt + 128 * 64}; pg8::gemm_phase<EpiResLN<false>>(lds, g, S, E); }
            }
        }
        if (ph_ + 1 < p.ph_hi) { if (sub == 1 || sub == 2) __syncthreads(); else { XcdBarrier xl = xb; xl.x = __builtin_amdgcn_readfirstlane(xb_xcc_id()); asm volatile("" : "+s"(xl.bar), "+s"(xl.x)); xcd_barrier(xl);     } }
    }
}

extern "C" void kernel_launch(void* const* d_in, const int* in_sizes, int n_in, void* d_out, int out_size, void* d_ws, size_t ws_size, hipStream_t stream) {
    static int grid_blocks = 0;
    if (grid_blocks == 0) {
        if (n_in != 22 || out_size != T * DM || ws_size < WS_END) { fprintf(stderr, "kernel_launch: unexpected shapes n_in %d out %d ws %zu\n", n_in, out_size, ws_size); grid_blocks = -1; return; }
        int dev = 0, cus = 0, per_cu = 0;
        hipGetDevice(&dev); hipDeviceGetAttribute(&cus, hipDeviceAttributeMultiprocessorCount, dev);
        if (hipFuncSetAttribute((const void*)mega_fwd, hipFuncAttributeMaxDynamicSharedMemorySize, LDS_BYTES + 16) != hipSuccess) { fprintf(stderr, "hipFuncSetAttribute failed\n"); grid_blocks = -1; return; }
        hipOccupancyMaxActiveBlocksPerMultiprocessor(&per_cu, (const void*)mega_fwd, 512, LDS_BYTES + 16);
        if (per_cu < 1) per_cu = 1;
        grid_blocks = cus * per_cu;
        (void)hipGetLastError();
    }
    if (grid_blocks < 0) return;
    Params p{};
    for (int i = 0; i < 22; ++i) p.in[i] = (const float*)d_in[i];
    p.out = (float*)d_out; p.ws = (unsigned char*)d_ws;
    for (int j = 0; j < 32; ++j) { const float e = (float)(2 * j) / 64.0f; p.invf[j] = 1.0f / powf(10000.0f, e); }
    p.ph_lo = 0; p.ph_hi = N_PHASES;
    void* args[] = {&p};
    hipError_t e = hipLaunchCooperativeKernel((const void*)mega_fwd, dim3(grid_blocks), dim3(512), args, LDS_BYTES + 16, stream);
    if (e != hipSuccess) {
        fprintf(stderr, "cooperative launch failed: %s (grid %d); falling back to one launch per phase\n", hipGetErrorString(e), grid_blocks);
        (void)hipGetLastError();
        for (int ph = 0; ph < N_PHASES; ++ph) { p.ph_lo = ph; p.ph_hi = ph + 1; hipLaunchKernelGGL(mega_fwd, dim3(grid_blocks), dim3(512), LDS_BYTES + 16, stream, p); }
    }
}
```

```cpp
#include <hip/hip_runtime.h>
#include <hip/hip_cooperative_groups.h>
#include <cstdio>
#include <cstdint>
#include <cmath>
namespace cg = cooperative_groups;

#define LAS __attribute__((address_space(3)))
typedef _Float16 f16;
typedef _Float16 half8 __attribute__((ext_vector_type(8)));
typedef _Float16 half4 __attribute__((ext_vector_type(4)));
typedef _Float16 half2v __attribute__((ext_vector_type(2)));
typedef short s16x8 __attribute__((ext_vector_type(8)));
typedef short s16x4 __attribute__((ext_vector_type(4)));
typedef float f32x2 __attribute__((ext_vector_type(2)));
typedef float f32x4 __attribute__((ext_vector_type(4)));
typedef float f32x16 __attribute__((ext_vector_type(16)));
typedef unsigned u32x4 __attribute__((ext_vector_type(4)));
typedef unsigned u32x2 __attribute__((ext_vector_type(2)));

constexpr int T = 32768, TP = 16384, DM = 1024, DINP = 1280, DFF = 2816, NL = 4;
constexpr int LDQ = 768, LDK = 768, LDV = 512, LDC = 1024, LDU = 1280;
constexpr float ALPHA = 1.6817928305074290f;
constexpr float LN_EPS = 1e-5f, RMS_EPS = 1e-6f;
constexpr float QSCALE = 0.07216878364870323f * 1.4426950408889634f;
constexpr size_t MiB = 1u << 20;
constexpr size_t WS_SSQ_Q = 0, WS_SSQ_KV = 128 * 1024;
constexpr size_t WS_CNT = 256 * 1024;
constexpr size_t WS_BAR = 512 * 1024;
constexpr size_t WS_COS = 1 * MiB, WS_SIN = 3 * MiB;
constexpr size_t WS_WIN = 5 * MiB, WS_WUQ = WS_WIN + (size_t)DINP * DM * 2, WS_WUKV = WS_WUQ + 768 * 256 * 2, WS_WOUT = WS_WUKV + 1024 * 128 * 2;
constexpr size_t WS_WGU = 11 * MiB, WS_WD = 22 * MiB;
constexpr size_t WS_U = 28 * MiB;
constexpr size_t WS_H = 108 * MiB;
constexpr size_t WS_K = WS_H, WS_V = WS_H + 48 * MiB, WS_CAT = WS_H + 80 * MiB;
constexpr size_t WS_XBUF = 284 * MiB;
constexpr size_t WS_END = 285 * MiB;
static_assert(WS_WOUT + (size_t)DM * DM * 2 <= WS_WGU && WS_WD + (size_t)DM * DFF * 2 <= WS_U, "ws map");
constexpr size_t DO_XH = 0, DO_Q = 64 * MiB;

struct Params { const float* in[22]; float* out; unsigned char* ws; float invf[32]; int ph_lo, ph_hi; };
enum { I_XP = 0, I_XS, I_WIN, I_WDW, I_BDW, I_GCN, I_BCN, I_WPW, I_WPOOL, I_PSC, I_GQ, I_GKV, I_WUQ, I_WUKV, I_WOUT, I_LN1G, I_LN1B, I_WG, I_WU, I_WD, I_LN2G, I_LN2B };

__device__ __forceinline__ unsigned cvtpk(float lo, float hi) { f32x2 v = {lo, hi}; half2v h = __builtin_convertvector(v, half2v); return __builtin_bit_cast(unsigned, h); }
__device__ __forceinline__ u32x4 pack8(f32x4 a, f32x4 b) { u32x4 w; w.x = cvtpk(a[0], a[1]); w.y = cvtpk(a[2], a[3]); w.z = cvtpk(b[0], b[1]); w.w = cvtpk(b[2], b[3]); return w; }
typedef int v8i __attribute__((ext_vector_type(8)));
typedef int v4i __attribute__((ext_vector_type(4)));
__device__ __forceinline__ unsigned pk4_fp8(float a, float b, float c, float d) { int w = 0; w = __builtin_amdgcn_cvt_pk_fp8_f32(a, b, w, false); w = __builtin_amdgcn_cvt_pk_fp8_f32(c, d, w, true); return (unsigned)w; }
__device__ __forceinline__ unsigned char one_fp8(float a) { return (unsigned char)(__builtin_amdgcn_cvt_pk_fp8_f32(a, a, 0, false) & 0xFF); }
__device__ __forceinline__ float wave_sum(float v) {
#pragma unroll
    for (int o = 1; o < 64; o <<= 1) v += __shfl_xor(v, o);
    return v;
}
__device__ __forceinline__ int otid() { int t = threadIdx.x; asm volatile("" : "+v"(t)); return t; }
__device__ __forceinline__ int obx() { int t = blockIdx.x; asm volatile("" : "+s"(t)); return t; }
__device__ __forceinline__ int ogd() { int t = gridDim.x; asm volatile("" : "+s"(t)); return t; }
__device__ __forceinline__ int posof(int row) { return row < TP ? row : (row & 4095); }
__device__ __forceinline__ float sigmoidf_(float x) { return __builtin_amdgcn_rcpf(1.0f + __expf(-x)); }

namespace pg8 {
constexpr int BM = 256, BK = 64, HALF = 128, HTB = HALF * BK * 2, STAGE_BYTES = 8 * HTB, NXCD = 8, WGM = 8;
__device__ __forceinline__ int lds_byte(int r, int c) { const int st = (r >> 4) * 2 + (c >> 5), rr = r & 15, cc = c & 31, ob = rr * 64 + cc * 2; return st * 1024 + (ob ^ (((ob >> 9) & 1) << 5)); }
__device__ __forceinline__ void stage_rc(int b, int& R, int& C) { const int st = b / 1024, sb = b % 1024, swz = sb ^ (((sb >> 9) & 1) << 5); R = (st >> 1) * 16 + swz / 64; C = (st & 1) * 32 + (swz % 64) / 2; }
__device__ __forceinline__ int perm32(int rho) { const int n = rho >> 4, i = rho & 15; return 8 * (i >> 2) + 4 * n + (i & 3); }
struct Unit { int pm, pn; };
struct Gemm { const f16* A; const f16* Bt; int lda, ldb, M, N, K; };
struct StaticOrder {
    int nM, nN, nwg, G, c; bool panel = false;
    __device__ void init(int M, int N, int G_, int c_) { nM = M / BM; nN = N / BM; nwg = nM * nN; G = G_; c = c_; }
    __device__ bool next(int i, Unit& u) const {
        if (panel) { const int ge = G & ~3; if (c >= ge) return false; const int idx = i * (ge >> 2) + (c >> 2); if (idx >= nM) return false; u.pm = idx; u.pn = c & 3; return true; }
        const long L = (long)i * G + c; if (L >= nwg) return false;
        int wgid = (int)L; { const int q = nwg / NXCD, r = nwg % NXCD, xcd = wgid % NXCD, off = wgid / NXCD; wgid = (xcd < r ? xcd * (q + 1) : r * (q + 1) + (xcd - r) * q) + off; }
        const int nig = WGM * nN, gid = wgid / nig, fm = gid * WGM, gsz = (nM - fm) < WGM ? (nM - fm) : WGM;
        u.pm = fm + ((wgid % nig) % gsz); u.pn = (wgid % nig) / gsz; return true;
    }
};
template <class Epi>
__device__ __forceinline__ void gemm_phase(LAS unsigned char* lds, const Gemm g, const StaticOrder& S, const Epi& E) {
    const int tid = otid(), wid = __builtin_amdgcn_readfirstlane(tid >> 6), lane = tid & 63, wr = wid >> 2, wc = wid & 3, fr = lane & 15, fq = lane >> 4;
    int nt = g.K / BK; asm volatile("" : "+s"(nt));
    unsigned voffA[2], voffB[2];
#pragma unroll
    for (int i = 0; i < 2; ++i) { int R, C; stage_rc(tid * 16 + i * 8192, R, C); const int Rb = (R & ~31) + perm32(R & 31);
        voffA[i] = (unsigned)(R * g.lda + C) * 2u; voffB[i] = (unsigned)(Rb * g.ldb + C) * 2u; }
    const size_t kstep = (size_t)(BK * 2);
    const size_t hA = (size_t)HALF * g.lda * 2, hB = (size_t)HALF * g.ldb * 2, tA = 2 * hA, tB = 2 * hB;
    const unsigned ldsw = (unsigned)wid * 1024u;
    const int aoff = lds_byte(wr * 64 + fr, fq * 8), boff = lds_byte(wc * 32 + fr, fq * 8);
#define PG8_SA(b, h) (((b) * 2 + (h)) * HTB)
#define PG8_SB(b, h) ((4 + (b) * 2 + (h)) * HTB)
#define PG8_STAGE(bufoff, gbase, voff) do { _Pragma("unroll") for (int _i = 0; _i < 2; ++_i) \
        __builtin_amdgcn_global_load_lds((const unsigned*)((const char*)(gbase) + (voff)[_i]), (LAS unsigned*)(lds + (bufoff) + ldsw + _i * 8192), 16, 0, 0); } while (0)
#define PG8_LDA(dst, b, h) do { _Pragma("unroll") for (int m = 0; m < 4; ++m) _Pragma("unroll") for (int k = 0; k < 2; ++k) dst[m][k] = *(const LAS half8*)(lds + PG8_SA(b, h) + aoff + m * 2048 + k * 1024); } while (0)
#define PG8_LDB(dst, b, h) do { _Pragma("unroll") for (int n = 0; n < 2; ++n) _Pragma("unroll") for (int k = 0; k < 2; ++k) dst[n][k] = *(const LAS half8*)(lds + PG8_SB(b, h) + boff + n * 2048 + k * 1024); } while (0)
#define PG8_MMA(ai, bj, At, Bt) do { __builtin_amdgcn_s_setprio(1); _Pragma("unroll") for (int m = 0; m < 4; ++m) _Pragma("unroll") for (int n = 0; n < 2; ++n) _Pragma("unroll") for (int k = 0; k < 2; ++k) \
        acc[ai][bj][m][n] = __builtin_amdgcn_mfma_f32_16x16x32_f16(Bt[n][k], At[m][k], acc[ai][bj][m][n], 0, 0, 0); __builtin_amdgcn_s_setprio(0); } while (0)
#define PG8_WAIT_V(n) asm volatile("s_waitcnt vmcnt(" #n ")" ::: "memory")
#define PG8_WAIT_L(n) asm volatile("s_waitcnt lgkmcnt(" #n ")" ::: "memory")
#define PG8_BAR __builtin_amdgcn_s_barrier()
#define PG8_SCHED __builtin_amdgcn_sched_barrier(0)
    Unit cur, nxt; int ui = 0;
    if (!S.next(0, cur)) return;
    f32x4 acc[2][2][4][2];
#pragma unroll
    for (int a = 0; a < 2; ++a)
#pragma unroll
        for (int b = 0; b < 2; ++b)
#pragma unroll
            for (int m = 0; m < 4; ++m)
#pragma unroll
                for (int n = 0; n < 2; ++n) acc[a][b][m][n] = (f32x4){0.f, 0.f, 0.f, 0.f};
    half8 At[4][2], B0[2][2], B1[2][2];
    const char* cA = (const char*)g.A + (size_t)cur.pm * tA; const char* cB = (const char*)g.Bt + (size_t)cur.pn * tB;
    PG8_STAGE(PG8_SB(0, 0), cB, voffB); PG8_STAGE(PG8_SB(0, 1), cB + hB, voffB); PG8_STAGE(PG8_SA(0, 0), cA, voffA); PG8_STAGE(PG8_SA(0, 1), cA + hA, voffA);
    if (wr == 1) PG8_BAR;
    PG8_WAIT_V(2); PG8_BAR;
    PG8_STAGE(PG8_SB(1, 0), cB + kstep, voffB); PG8_STAGE(PG8_SA(1, 0), cA + kstep, voffA); PG8_STAGE(PG8_SB(1, 1), cB + hB + kstep, voffB);
    PG8_WAIT_V(6); PG8_BAR;
    for (;;) {
        const bool has_next = S.next(ui + 1, nxt);
        const char* nA = has_next ? (const char*)g.A + (size_t)nxt.pm * tA : cA; const char* nB = has_next ? (const char*)g.Bt + (size_t)nxt.pn * tB : cB;
        for (int t = 0; t < nt; t += 2) {
            const bool last = (t == nt - 2);
            const char* a1 = cA + (size_t)(t + 1) * kstep;
            const char* a2 = last ? nA : cA + (size_t)(t + 2) * kstep; const char* b2 = last ? nB : cB + (size_t)(t + 2) * kstep;
            const char* a3 = a2 + kstep; const char* b3 = b2 + kstep;
            PG8_LDB(B0, 0, 0); PG8_LDB(B1, 0, 1); PG8_SCHED; PG8_LDA(At, 0, 0); PG8_STAGE(PG8_SA(1, 1), a1 + hA, voffA);
            PG8_WAIT_V(8); PG8_WAIT_L(0); PG8_BAR; PG8_MMA(0, 0, At, B0); PG8_MMA(0, 1, At, B1); PG8_BAR; PG8_SCHED;
            PG8_LDA(At, 0, 1); PG8_STAGE(PG8_SB(0, 0), b2, voffB); PG8_STAGE(PG8_SB(0, 1), b2 + hB, voffB); PG8_STAGE(PG8_SA(0, 0), a2, voffA);
            PG8_WAIT_V(8); PG8_WAIT_L(0); PG8_BAR; PG8_MMA(1, 0, At, B0); PG8_MMA(1, 1, At, B1); PG8_BAR; PG8_SCHED;
            PG8_LDB(B0, 1, 0); PG8_LDB(B1, 1, 1); PG8_SCHED; PG8_LDA(At, 1, 0); PG8_STAGE(PG8_SA(0, 1), a2 + hA, voffA);
            PG8_WAIT_V(8); PG8_WAIT_L(0); PG8_BAR; PG8_MMA(0, 0, At, B0); PG8_MMA(0, 1, At, B1); PG8_BAR; PG8_SCHED;
            PG8_LDA(At, 1, 1); PG8_STAGE(PG8_SB(1, 0), b3, voffB); PG8_STAGE(PG8_SB(1, 1), b3 + hB, voffB); PG8_STAGE(PG8_SA(1, 0), a3, voffA);
            PG8_WAIT_V(8); PG8_WAIT_L(0); PG8_BAR; PG8_MMA(1, 0, At, B0); PG8_MMA(1, 1, At, B1); PG8_BAR; PG8_SCHED;
        }
        if (wr == 0) PG8_BAR;
        { const int t2 = otid(), w2 = t2 >> 6, l2 = t2 & 63;
          if constexpr (Epi::FUSED_LN) E.fused(acc, cur, w2 >> 2, w2 & 3, l2 & 15, l2 >> 4, lds + STAGE_BYTES, t2);
          else E(acc, cur, w2 >> 2, w2 & 3, l2 & 15, l2 >> 4); }
        if (!has_next) break;
#pragma unroll
        for (int a = 0; a < 2; ++a)
#pragma unroll
            for (int b = 0; b < 2; ++b)
#pragma unroll
                for (int m = 0; m < 4; ++m)
#pragma unroll
                    for (int n = 0; n < 2; ++n) acc[a][b][m][n] = (f32x4){0.f, 0.f, 0.f, 0.f};
        cur = nxt; cA = nA; cB = nB; ++ui;
        if (wr == 1) PG8_BAR;
    }
    PG8_WAIT_V(0);
    PG8_BAR;
#undef PG8_SA
#undef PG8_SB
#undef PG8_STAGE
#undef PG8_LDA
#undef PG8_LDB
#undef PG8_MMA
#undef PG8_WAIT_V
#undef PG8_WAIT_L
#undef PG8_BAR
#undef PG8_SCHED
}
}
using pg8::Unit;
typedef f32x4 AccT[2][2][4][2];
#define EPI_ROW(u, ai, m) ((u).pm * 256 + (ai) * 128 + wr * 64 + (m) * 16 + fr)
#define EPI_COL(u, bj) ((u).pn * 256 + (bj) * 128 + wc * 32 + 8 * fq)

__device__ __forceinline__ void rope8(f32x4& v0, f32x4& v1, f32x4 c4, f32x4 s4) {
    f32x4 a, b;
    a[0] = v0[0] * c4[0] - v0[1] * s4[0]; a[1] = v0[0] * s4[0] + v0[1] * c4[0];
    a[2] = v0[2] * c4[1] - v0[3] * s4[1]; a[3] = v0[2] * s4[1] + v0[3] * c4[1];
    b[0] = v1[0] * c4[2] - v1[1] * s4[2]; b[1] = v1[0] * s4[2] + v1[1] * c4[2];
    b[2] = v1[2] * c4[3] - v1[3] * s4[3]; b[3] = v1[2] * s4[3] + v1[3] * c4[3];
    v0 = a; v1 = b;
}
__device__ __forceinline__ float sumsq4(f32x4 x) { return (x[0] * x[0] + x[1] * x[1]) + (x[2] * x[2] + x[3] * x[3]); }

struct EpiA {
    static constexpr bool FUSED_LN = false;
    f16* U; float* ssq_q; float* ssq_kv;
    __device__ __forceinline__ void operator()(const AccT& acc, const Unit& u, int wr, int wc, int fr, int fq) const {
#pragma unroll
        for (int ai = 0; ai < 2; ++ai)
#pragma unroll
            for (int m = 0; m < 4; ++m) {
                const int row = EPI_ROW(u, ai, m);
#pragma unroll
                for (int bj = 0; bj < 2; ++bj) *(u32x4*)(U + (size_t)row * LDU + EPI_COL(u, bj)) = pack8(acc[ai][bj][m][0], acc[ai][bj][m][1]);
            }
        if (u.pn >= 3) {
            float* sp = u.pn == 3 ? ssq_q : ssq_kv; const float w1 = u.pn == 3 ? 1.f : 0.f;
#pragma unroll
            for (int ai = 0; ai < 2; ++ai)
#pragma unroll
                for (int m = 0; m < 4; ++m) {
                    float s = (sumsq4(acc[ai][0][m][0]) + sumsq4(acc[ai][0][m][1])) + w1 * (sumsq4(acc[ai][1][m][0]) + sumsq4(acc[ai][1][m][1]));
                    s += __shfl_xor(s, 16); s += __shfl_xor(s, 32);
                    if (fq == 0) unsafeAtomicAdd(sp + EPI_ROW(u, ai, m), s);
                }
        }
    }
};
struct EpiQ {
    static constexpr bool FUSED_LN = false;
    unsigned char* Q; const float* ssq_q; const float* cosT; const float* sinT;
    __device__ __forceinline__ void operator()(const AccT& acc, const Unit& u, int wr, int wc, int fr, int fq) const {
#pragma unroll
        for (int ai = 0; ai < 2; ++ai)
#pragma unroll
            for (int m = 0; m < 4; ++m) {
                const int row = EPI_ROW(u, ai, m);
                const float r = __builtin_amdgcn_rsqf(ssq_q[row] * (1.0f / 256.0f) + RMS_EPS);
                const int pos = posof(row);
#pragma unroll
                for (int bj = 0; bj < 2; ++bj) {
                    const int col = EPI_COL(u, bj), d = col % 192;
                    f32x4 v0 = acc[ai][bj][m][0] * r, v1 = acc[ai][bj][m][1] * r;
                    if (d >= 128) { const int j0 = (d - 128) >> 1;
                        const f32x4 c4 = *(const f32x4*)(cosT + pos * 32 + j0), s4 = *(const f32x4*)(sinT + pos * 32 + j0);
                        rope8(v0, v1, c4, s4); }
                    u32x2 w; w.x = pk4_fp8(v0[0], v0[1], v0[2], v0[3]); w.y = pk4_fp8(v1[0], v1[1], v1[2], v1[3]);
                    *(u32x2*)(Q + (size_t)row * LDQ + col) = w;
                }
            }
    }
};
struct EpiKV {
    static constexpr bool FUSED_LN = false;
    unsigned char* Kb; unsigned char* VT; const float* ssq_kv;
    __device__ __forceinline__ void operator()(const AccT& acc, const Unit& u, int wr, int wc, int fr, int fq) const {
#pragma unroll
        for (int ai = 0; ai < 2; ++ai)
#pragma unroll
            for (int m = 0; m < 4; ++m) {
                const int row = EPI_ROW(u, ai, m);
                const float r = __builtin_amdgcn_rsqf(ssq_kv[row] * (1.0f / 128.0f) + RMS_EPS);
                const int c = wc * 32 + 8 * fq;
                const f32x4 k0 = acc[ai][0][m][0] * r, k1 = acc[ai][0][m][1] * r;
                u32x2 w; w.x = pk4_fp8(k0[0], k0[1], k0[2], k0[3]); w.y = pk4_fp8(k1[0], k1[1], k1[2], k1[3]);
                *(u32x2*)(Kb + (size_t)row * LDK + 192 * u.pn + c) = w;
                const int tile = row >> 6, k = row & 63, a = k >> 5, cc = k & 31, pos = 32 * ((cc >> 2) & 1) + 16 * a + (cc & 3) + 4 * (cc >> 3);
                unsigned char* vt = VT + ((size_t)(u.pn * (T / 64) + tile) * 128 + c) * 64 + (pos & 15);
#pragma unroll
                for (int e = 0; e < 8; ++e) { const float v = (e < 4 ? acc[ai][1][m][0][e & 3] : acc[ai][1][m][1][e & 3]) * r;
                    vt[e * 64 + ((((pos >> 4) ^ (((c + e) >> 2) & 3)) & 3) << 4)] = one_fp8(v); }
            }
    }
};
template <bool F32OUT> struct EpiRes {
    static constexpr bool FUSED_LN = false;
    const f16* res; f16* o16; float* o32;
    __device__ __forceinline__ void operator()(const AccT& acc, const Unit& u, int wr, int wc, int fr, int fq) const {
#pragma unroll
        for (int ai = 0; ai < 2; ++ai)
#pragma unroll
            for (int m = 0; m < 4; ++m) {
                const int row = EPI_ROW(u, ai, m);
#pragma unroll
                for (int bj = 0; bj < 2; ++bj) {
                    const size_t off = (size_t)row * DM + EPI_COL(u, bj);
                    const half8 rv = *(const half8*)(res + off);
                    f32x4 v0 = acc[ai][bj][m][0], v1 = acc[ai][bj][m][1];
#pragma unroll
                    for (int e = 0; e < 4; ++e) { v0[e] += ALPHA * (float)rv[e]; v1[e] += ALPHA * (float)rv[4 + e]; }
                    if (F32OUT) { *(f32x4*)(o32 + off) = v0; *(f32x4*)(o32 + off + 4) = v1; }
                    else *(u32x4*)(o16 + off) = pack8(v0, v1);
                }
            }
    }
};
template <bool F32OUT> struct EpiResLN {
    static constexpr bool FUSED_LN = true;
    const f16* res; f16* o16; float* o32; const float* g; const float* b; unsigned long long* xbuf; unsigned* cnt;
    __device__ __forceinline__ void fused(AccT& acc, const Unit& u, int wr, int wc, int fr, int fq, LAS unsigned char* lx, int tid) const {
        LAS f32x2* P = (LAS f32x2*)lx;
        LAS f32x2* Sx = (LAS f32x2*)(lx + 8192);
        LAS unsigned* flag = (LAS unsigned*)(lx + 8192 + 2048);
#pragma unroll
        for (int ai = 0; ai < 2; ++ai)
#pragma unroll
            for (int m = 0; m < 4; ++m) {
                const int row = EPI_ROW(u, ai, m); float s1 = 0.f, s2 = 0.f;
#pragma unroll
                for (int bj = 0; bj < 2; ++bj) {
                    const half8 rv = *(const half8*)(res + (size_t)row * DM + EPI_COL(u, bj));
#pragma unroll
                    for (int e = 0; e < 4; ++e) { acc[ai][bj][m][0][e] += ALPHA * (float)rv[e]; acc[ai][bj][m][1][e] += ALPHA * (float)rv[4 + e]; }
                    const f32x4 a0 = acc[ai][bj][m][0], a1 = acc[ai][bj][m][1];
                    s1 += ((a0[0] + a0[1]) + (a0[2] + a0[3])) + ((a1[0] + a1[1]) + (a1[2] + a1[3])); s2 += sumsq4(a0) + sumsq4(a1);
                }
                s1 += __shfl_xor(s1, 16); s1 += __shfl_xor(s1, 32); s2 += __shfl_xor(s2, 16); s2 += __shfl_xor(s2, 32);
                if (fq == 0) P[(ai * 128 + wr * 64 + m * 16 + fr) * 4 + wc] = (f32x2){s1, s2};
            }
        asm volatile("s_waitcnt lgkmcnt(0)" ::: "memory"); __builtin_amdgcn_s_barrier(); asm volatile("" ::: "memory");
        if (tid < 256) {
            const f32x2 a = P[tid * 4 + 0], b2 = P[tid * 4 + 1], c = P[tid * 4 + 2], d = P[tid * 4 + 3];
            const float S1 = (a.x + b2.x) + (c.x + d.x), S2 = (a.y + b2.y) + (c.y + d.y);
            __hip_atomic_store(xbuf + ((size_t)(u.pm * 256 + tid) * 4 + u.pn), ((unsigned long long)__float_as_uint(S2) << 32) | __float_as_uint(S1), __ATOMIC_RELAXED, __HIP_MEMORY_SCOPE_AGENT);
            asm volatile("s_waitcnt vmcnt(0)" ::: "memory");
            if ((tid & 63) == 0) __hip_atomic_fetch_add(cnt + 64 * u.pm, 1u, __ATOMIC_RELAXED, __HIP_MEMORY_SCOPE_AGENT);
        }
        if (tid < 64) {
            unsigned spins = 0;
            while ((unsigned)__builtin_amdgcn_readfirstlane(__hip_atomic_load(cnt + 64 * u.pm, __ATOMIC_RELAXED, __HIP_MEMORY_SCOPE_AGENT)) < 16u) { __builtin_amdgcn_s_sleep(2); if (++spins > (1u << 22)) break; }
            __builtin_amdgcn_fence(__ATOMIC_ACQUIRE, "agent");
            if (tid == 0) flag[0] = 1u;
        }
        asm volatile("s_waitcnt vmcnt(0) lgkmcnt(0)" ::: "memory"); __builtin_amdgcn_s_barrier(); asm volatile("" ::: "memory");
        if (tid < 256) {
            const unsigned long long* slot = xbuf + (size_t)(u.pm * 256 + tid) * 4; float S1 = 0.f, S2 = 0.f;
#pragma unroll
            for (int t = 0; t < 4; ++t) { const unsigned long long w = __hip_atomic_load(slot + t, __ATOMIC_RELAXED, __HIP_MEMORY_SCOPE_AGENT); S1 += __uint_as_float((unsigned)w); S2 += __uint_as_float((unsigned)(w >> 32)); }
            const float mean = S1 * (1.0f / DM), var = fmaxf(S2 * (1.0f / DM) - mean * mean, 0.f);
            Sx[tid] = (f32x2){mean, 1.0f / sqrtf(var + LN_EPS)};
        }
        asm volatile("s_waitcnt lgkmcnt(0)" ::: "memory"); __builtin_amdgcn_s_barrier(); asm volatile("" ::: "memory");
        f32x4 gv[2][2], bv[2][2];
#pragma unroll
        for (int bj = 0; bj < 2; ++bj)
#pragma unroll
            for (int n = 0; n < 2; ++n) { gv[bj][n] = *(const f32x4*)(g + EPI_COL(u, bj) + 4 * n); bv[bj][n] = *(const f32x4*)(b + EPI_COL(u, bj) + 4 * n); }
#pragma unroll
        for (int ai = 0; ai < 2; ++ai)
#pragma unroll
            for (int m = 0; m < 4; ++m) {
                const int row = EPI_ROW(u, ai, m); const f32x2 st = Sx[ai * 128 + wr * 64 + m * 16 + fr];
#pragma unroll
                for (int bj = 0; bj < 2; ++bj) {
                    const size_t off = (size_t)row * DM + EPI_COL(u, bj);
                    const f32x4 y0 = (acc[ai][bj][m][0] - st.x) * st.y * gv[bj][0] + bv[bj][0], y1 = (acc[ai][bj][m][1] - st.x) * st.y * gv[bj][1] + bv[bj][1];
                    if (F32OUT) { *(f32x4*)(o32 + off) = y0; *(f32x4*)(o32 + off + 4) = y1; }
                    else *(u32x4*)(o16 + off) = pack8(y0, y1);
                }
            }
    }
};
struct EpiGLU {
    static constexpr bool FUSED_LN = false;
    f16* H;
    __device__ __forceinline__ void operator()(const AccT& acc, const Unit& u, int wr, int wc, int fr, int fq) const {
#pragma unroll
        for (int ai = 0; ai < 2; ++ai)
#pragma unroll
            for (int m = 0; m < 4; ++m) {
                const int row = EPI_ROW(u, ai, m);
                f32x4 h0, h1;
#pragma unroll
                for (int e = 0; e < 4; ++e) { const float g0 = acc[ai][0][m][0][e], g1 = acc[ai][0][m][1][e];
                    h0[e] = g0 * sigmoidf_(g0) * acc[ai][1][m][0][e]; h1[e] = g1 * sigmoidf_(g1) * acc[ai][1][m][1][e]; }
                *(u32x4*)(H + (size_t)row * DFF + u.pn * 128 + wc * 32 + 8 * fq) = pack8(h0, h1);
            }
    }
};

#ifndef ATT_QREG
#define ATT_QREG 6
#endif
#ifndef ATT_SDEPTH
#define ATT_SDEPTH 1
#endif
namespace att {
constexpr int SHM_V = 64 * 128 * 2, SHM_K = 64 * 192 * 2, KRING = 3 * SHM_V, SHM_WS = 3 * SHM_V + 2 * SHM_K, SHM_Q = SHM_WS + 8 * 64 * 4, QREG = ATT_QREG, QLDS = 12 - QREG, SHM_TOTAL = 100352;
constexpr float THR2 = 8.f * 1.4426950408889634f;
#define KSWZ(row, colB) ((row) * 384 + ((colB) ^ (((row) & 7) << 4)))
#define SBAR() __builtin_amdgcn_sched_barrier(0)
__device__ __forceinline__ int crow(int r, int hi) { return (r & 3) + 8 * (r >> 2) + 4 * hi; }
constexpr float CQ = QSCALE;
constexpr float SH = 4.f;
constexpr float THRQ = 4.f / CQ;
constexpr int VT_TILE = 8192, K_TILE = 12288, VT_SLOT = 2 * VT_TILE, K_SLOT = 2 * K_TILE, KRING8 = 3 * VT_SLOT, WS8 = KRING8 + 2 * K_SLOT, SHM8 = WS8 + 8 * 64 * 4;
constexpr float THRL = 4.f;
template <bool FIRST>
__device__ __forceinline__ void partialSM(f32x16& p0, f32x16& p1, f32x16& negm, float& dl, float& alpha) {
    float pmax = p0[0];
#pragma unroll
    for (int r = 1; r < 16; ++r) pmax = fmaxf(pmax, p0[r]);
#pragma unroll
    for (int r = 0; r < 16; ++r) pmax = fmaxf(pmax, p1[r]);
    { auto rr = __builtin_amdgcn_permlane32_swap(__float_as_uint(pmax), __float_as_uint(pmax), false, false);
      pmax = fmaxf(__uint_as_float(rr[0]), __uint_as_float(rr[1])); }
    if (FIRST) {
        dl = 0.f; alpha = 1.f; const float d0_ = pmax - SH;
#pragma unroll
        for (int r = 0; r < 16; ++r) { p0[r] -= d0_; p1[r] -= d0_; negm[r] -= d0_; }
    } else {
        const bool keep = __all(pmax <= SH + THRL);
        dl = keep ? 0.f : fmaxf(pmax - SH, 0.f); alpha = __builtin_amdgcn_exp2f(-dl);
    }
#pragma unroll
    for (int r = 0; r < 16; ++r) p0[r] = __builtin_amdgcn_exp2f(p0[r]);
}
__device__ __forceinline__ void finishSM(f32x16& p0, f32x16& p1, v8i& pa) {
#pragma unroll
    for (int r = 0; r < 16; ++r) p1[r] = __builtin_amdgcn_exp2f(p1[r]);
#pragma unroll
    for (int w = 0; w < 4; ++w) { pa[w] = (int)pk4_fp8(p0[4 * w], p0[4 * w + 1], p0[4 * w + 2], p0[4 * w + 3]); pa[4 + w] = (int)pk4_fp8(p1[4 * w], p1[4 * w + 1], p1[4 * w + 2], p1[4 * w + 3]); }
}
#define MFMA8(A, B, C) __builtin_amdgcn_mfma_scale_f32_32x32x64_f8f6f4(A, B, C, 0, 0, 0, 0x7F7F7F7F, 0, 0x7F7F7F7F)
__device__ __forceinline__ v8i ld32(const LAS char* a0, const LAS char* a1) { const v4i x = *(const LAS v4i*)a0, y = *(const LAS v4i*)a1; return (v8i){x[0], x[1], x[2], x[3], y[0], y[1], y[2], y[3]}; }
#define MFMA8QK(A, B, C) __builtin_amdgcn_mfma_scale_f32_32x32x64_f8f6f4(A, B, C, 0, 0, 0, 0x7F7F7F7F, 0, 0x7C7C7C7C)
__device__ __forceinline__ void qkt(f32x16& p0, f32x16& p1, const LAS char* Ks, int ka0, int ka1, const v8i* qf, const f32x16& negm) {
#pragma unroll
    for (int st = 0; st < 3; ++st) {
        const v8i k0 = ld32(Ks + ka0 + 64 * st, Ks + ka1 + 64 * st), k1 = ld32(Ks + ka0 + 64 * st + 32 * 192, Ks + ka1 + 64 * st + 32 * 192);
        if (st == 0) { p0 = MFMA8QK(k0, qf[st], negm); p1 = MFMA8QK(k1, qf[st], negm); }
        else { p0 = MFMA8QK(k0, qf[st], p0); p1 = MFMA8QK(k1, qf[st], p1); } }
}
__device__ __forceinline__ void pv_d0(f32x16* o, const LAS char* Vs, int va0, int va1, v8i pa) {
#pragma unroll
    for (int d0 = 0; d0 < 4; ++d0) { const v8i vf = ld32(Vs + va0 + 2048 * d0, Vs + va1 + 2048 * d0); o[d0] = MFMA8(pa, vf, o[d0]); }
    const v8i ones = {0x38383838, 0x38383838, 0x38383838, 0x38383838, 0x38383838, 0x38383838, 0x38383838, 0x38383838};
    o[4] = MFMA8(pa, ones, o[4]);
}
__device__ __forceinline__ void attn_unit(const unsigned char* __restrict__ Qb, const unsigned char* __restrict__ Kh, const unsigned char* __restrict__ VTh, f16* __restrict__ Ob, int seq, LAS char* lds) {
    const int tid = otid(), wid = __builtin_amdgcn_readfirstlane(tid >> 6), lane = tid & 63, r32 = lane & 31, hi = lane >> 5;
    LAS float* ws = (LAS float*)(lds + WS8) + wid * 64; LAS float* li_l = ws; LAS float* al_l = ws + 32;
    f32x16 o[5] = {}; v8i qf[3]; f32x16 negm;
#pragma unroll
    for (int r = 0; r < 16; ++r) negm[r] = SH;
    const unsigned char* Qw = Qb + (long)(wid * 32 + r32) * LDQ + hi * 32;
#pragma unroll
    for (int st = 0; st < 3; ++st) { const v4i x = *(const v4i*)(Qw + 64 * st), y = *(const v4i*)(Qw + 64 * st + 16); qf[st] = (v8i){x[0], x[1], x[2], x[3], y[0], y[1], y[2], y[3]}; }
    const int sw = (r32 >> 2) & 3;
    const int ka0 = r32 * 192 + (((2 * hi) ^ sw) << 4), ka1 = r32 * 192 + (((2 * hi + 1) ^ sw) << 4);
    const int va0 = r32 * 64 + (((2 * hi) ^ sw) << 4), va1 = r32 * 64 + (((2 * hi + 1) ^ sw) << 4);
#define ISSUE(st) do { const int vo_ = ((st) % 3) * VT_SLOT, ko_ = KRING8 + ((st) & 1) * K_SLOT; const unsigned char* kp_ = Kh + (long)(st) * 128 * LDK; const unsigned char* vp_ = VTh + (long)(st) * (2 * 128 * 64); \
    const int ln_ = otid() & 63; \
    _Pragma("unroll") for (int i_ = 0; i_ < 5; ++i_) { const int c_ = wid + 8 * i_, t2_ = c_ / 20, cc_ = c_ % 20; unsigned go_; \
        if (cc_ < 8) go_ = (unsigned)(t2_ * (128 * 64) + cc_ * 1024 + ln_ * 16); \
        else { const int b_ = (cc_ - 8) * 1024 + ln_ * 16, row_ = b_ / 192, pc_ = (b_ % 192) >> 4, lc_ = pc_ ^ ((row_ >> 2) & 3); go_ = (unsigned)((t2_ * 64 + row_) * LDK + lc_ * 16); } \
        const unsigned char* g_ = (cc_ < 8 ? vp_ : kp_) + go_; \
        __builtin_amdgcn_global_load_lds((const unsigned*)g_, (LAS unsigned*)(lds + (cc_ < 8 ? vo_ + t2_ * VT_TILE + cc_ * 1024 : ko_ + t2_ * K_TILE + (cc_ - 8) * 1024)), 16, 0, 0); } } while (0)
#define WBAR() do { asm volatile("s_waitcnt vmcnt(0) lgkmcnt(0)" ::: "memory"); __builtin_amdgcn_s_barrier(); asm volatile("" ::: "memory"); } while (0)
#define FIX(a, dlt, P0, P1) do { if (__any((dlt) > 0.f)) { if (hi == 0) al_l[r32] = (a); asm volatile("s_waitcnt lgkmcnt(0)" ::: "memory"); \
    _Pragma("unroll") for (int d = 0; d < 5; ++d) _Pragma("unroll") for (int r = 0; r < 16; ++r) o[d][r] *= al_l[crow(r, hi)]; \
    _Pragma("unroll") for (int r = 0; r < 16; ++r) { P0[r] *= (a); P1[r] -= (dlt); negm[r] -= (dlt); } } } while (0)
#define KSL(tile) (lds + KRING8 + (((tile) >> 1) & 1) * K_SLOT + ((tile) & 1) * K_TILE)
#define VSL(tile) (lds + (((tile) >> 1) % 3) * VT_SLOT + ((tile) & 1) * VT_TILE)
    f32x16 pA0, pA1, pB0, pB1; float dlA, dlB, alA, alB; v8i pa; const int NT = seq / 64;
    const int NS = NT >> 1;
    WBAR();
    ISSUE(0);
    WBAR();
    if (1 < NS) ISSUE(1);
    qkt(pA0, pA1, KSL(0), ka0, ka1, qf, negm); partialSM<true>(pA0, pA1, negm, dlA, alA);
    for (int j = 1; j + 1 < NT; j += 2) {
        SBAR(); qkt(pB0, pB1, KSL(j), ka0, ka1, qf, negm);
        finishSM(pA0, pA1, pa); SBAR();
        pv_d0(o, VSL(j - 1), va0, va1, pa); partialSM<false>(pB0, pB1, negm, dlB, alB);
        WBAR();
        { const int J = (j - 1) >> 1; if (J + 2 < NS) ISSUE(J + 2); }
        FIX(alB, dlB, pB0, pB1);
        SBAR(); qkt(pA0, pA1, KSL(j + 1), ka0, ka1, qf, negm);
        finishSM(pB0, pB1, pa); SBAR();
        pv_d0(o, VSL(j), va0, va1, pa); partialSM<false>(pA0, pA1, negm, dlA, alA);
        FIX(alA, dlA, pA0, pA1);
    }
    SBAR(); qkt(pB0, pB1, KSL(NT - 1), ka0, ka1, qf, negm);
    finishSM(pA0, pA1, pa); SBAR();
    pv_d0(o, VSL(NT - 2), va0, va1, pa); partialSM<false>(pB0, pB1, negm, dlB, alB);
    FIX(alB, dlB, pB0, pB1);
    finishSM(pB0, pB1, pa); SBAR();
    pv_d0(o, VSL(NT - 1), va0, va1, pa);
    float rli[16];
#pragma unroll
    for (int r = 0; r < 16; ++r) rli[r] = __builtin_amdgcn_rcpf(o[4][r]);
    f16* Ow = Ob + (long)(wid * 32) * LDC;
#pragma unroll
    for (int r = 0; r < 16; ++r) { const int orow = crow(r, hi);
#pragma unroll
        for (int d0 = 0; d0 < 4; ++d0) Ow[(long)orow * LDC + d0 * 32 + r32] = (f16)(o[d0][r] * rli[r]); }
#undef ISSUE
#undef WBAR
#undef FIX
#undef KSL
#undef VSL
}
}

struct TrDesc { const float* src; const float* src2; const float* rs; f16* dst; int ld_src, ld_dst, k0, n0, mode; };
__device__ __forceinline__ void tr_load(const TrDesc& d, int tid, float (&v)[8]) {
    const int nn = tid & 63, np = d.n0 + nn; int col = np; const float* s = d.src;
    if (d.mode == 1) { if (np >= 1216) col = -1; else if (np >= 1152) { const int i = np - 1152; col = 1152 + (i >> 1) + 32 * (i & 1); } }
    else if (d.mode == 2) { const int h = np / 192, dd = np % 192; if (dd >= 128) { const int i = dd - 128; col = 192 * h + 128 + (i >> 1) + 32 * (i & 1); } }
    else if (d.mode == 3) { col = (np >> 8) * 128 + (np & 127); if ((np >> 7) & 1) s = d.src2; }
#pragma unroll
    for (int i = 0; i < 8; ++i) { const int kk = (tid >> 6) + 8 * i; float x = 0.f;
        if (col >= 0) { x = s[(size_t)(d.k0 + kk) * d.ld_src + col]; if (d.rs) x *= d.rs[d.k0 + kk]; if (d.mode == 2) x *= QSCALE * 8.0f; }
        v[i] = x; }
}
struct TrPtrs { const float* a; const float* b; const float* c; const float* d; const float* ga; const float* gb; f16* o0; f16* o1; f16* o2; f16* o3; };
template <int KIND> __device__ __forceinline__ TrDesc tr_desc(const TrPtrs& P, int it) {
    if (KIND == 0) {
        if (it < 320) return TrDesc{P.a, nullptr, nullptr, P.o0, 1216, DM, (it & 15) * 64, (it >> 4) * 64, 1};
        if (it < 368) { const int j = it - 320; return TrDesc{P.b, nullptr, P.ga, P.o1, 768, 256, (j & 3) * 64, (j >> 2) * 64, 2}; }
        if (it < 400) { const int j = it - 368; return TrDesc{P.c, nullptr, P.gb, P.o2, 1024, 128, (j & 1) * 64, (j >> 1) * 64, 0}; }
        const int j = it - 400; return TrDesc{P.d, nullptr, nullptr, P.o3, DM, DM, 512 + (j & 7) * 64, (j >> 3) * 64, 0};
    } else {
        if (it < 1408) return TrDesc{P.a, P.b, nullptr, P.o0, DFF, DM, (it & 15) * 64, (it >> 4) * 64, 3};
        const int j = it - 1408; return TrDesc{P.c, nullptr, nullptr, P.o1, DM, DFF, (j % 44) * 64, (j / 44) * 64, 0};
    }
}
template <int KIND>
__device__ __forceinline__ void tr_run(int first, int count, int stride, LAS float* scr, const TrPtrs P) {
    const int tid = otid();
    float v[8]; TrDesc d = tr_desc<KIND>(P, first < count ? first : 0); if (first < count) tr_load(d, tid, v); int buf = 0;
#pragma unroll 1
    for (int it = first; it < count; it += stride) {
        LAS float* sb = scr + buf * (64 * 65);
#pragma unroll
        for (int i = 0; i < 8; ++i) sb[((tid >> 6) + 8 * i) * 65 + (tid & 63)] = v[i];
        const TrDesc dc = d;
        if (it + stride < count) { d = tr_desc<KIND>(P, it + stride); tr_load(d, tid, v); }
        __syncthreads();
        { const int nn = tid >> 3, c8 = tid & 7; const LAS float* sp = sb + (c8 * 8) * 65 + nn;
          u32x4 w; w.x = cvtpk(sp[0], sp[65]); w.y = cvtpk(sp[2 * 65], sp[3 * 65]); w.z = cvtpk(sp[4 * 65], sp[5 * 65]); w.w = cvtpk(sp[6 * 65], sp[7 * 65]);
          *(u32x4*)(dc.dst + (size_t)(dc.n0 + nn) * dc.ld_dst + dc.k0 + c8 * 8) = w; }
        buf ^= 1;
    }
    __syncthreads();
}
__device__ __forceinline__ void conv_weights_A(const Params& p, int l, LAS float* scr) {
    unsigned char* ws = p.ws; const int G = ogd(), bx = obx();
    f16* WinT = (f16*)(ws + WS_WIN); f16* WuqT = (f16*)(ws + WS_WUQ); f16* WukvT = (f16*)(ws + WS_WUKV); f16* WoutT = (f16*)(ws + WS_WOUT);
    const float* w_in = p.in[I_WIN] + (size_t)l * DM * 1216; const float* w_uq = p.in[I_WUQ] + (size_t)l * 256 * 768; const float* w_ukv = p.in[I_WUKV] + (size_t)l * 128 * 1024;
    const float* w_out = p.in[I_WOUT] + (size_t)l * DM * DM; const float* g_q = p.in[I_GQ] + l * 256; const float* g_kv = p.in[I_GKV] + l * 128;
    const float* w_pw = p.in[I_WPW] + (size_t)l * 256 * 256; const float* w_pool = p.in[I_WPOOL] + (size_t)l * 4 * 64 * 64; const float* psc = p.in[I_PSC] + l * 256;
    tr_run<0>(bx, 528, G, scr, TrPtrs{w_in, w_uq, w_ukv, w_out, g_q, g_kv, WinT, WuqT, WukvT, WoutT});
    for (int idx = bx * 512 + otid(); idx < 128 * 1024; idx += G * 512) {
        const int k0 = (idx >> 10) * 4, n = idx & 1023; float a0 = 0.f, a1 = 0.f, a2 = 0.f, a3 = 0.f;
        if (k0 < 256) { const float* wp = w_pw + k0 * 256; const float* wo = w_out + n;
#pragma unroll 32
            for (int j = 0; j < 256; ++j) { const float bv = wo[(size_t)j * DM]; a0 += wp[j] * bv; a1 += wp[256 + j] * bv; a2 += wp[512 + j] * bv; a3 += wp[768 + j] * bv; } }
        else { const int g = (k0 - 256) >> 6, c = (k0 - 256) & 63; const float* wp = w_pool + (g * 64 + c) * 64; const float* sc = psc + 64 * g; const float* wo = w_out + (size_t)(256 + 64 * g) * DM + n;
#pragma unroll 32
               for (int j = 0; j < 64; ++j) { const float bv = sc[j] * wo[(size_t)j * DM]; a0 += wp[j] * bv; a1 += wp[64 + j] * bv; a2 += wp[128 + j] * bv; a3 += wp[192 + j] * bv; } }
        u32x2 w2; w2.x = cvtpk(a0, a1); w2.y = cvtpk(a2, a3);
        *(u32x2*)(WoutT + (size_t)n * DM + k0) = w2;
    }
}
__device__ __forceinline__ void conv_weights_F(const Params& p, int l, LAS float* scr, bool skew = false) {
    unsigned char* ws = p.ws; const int G = ogd(), bx = obx();
    f16* WguT = (f16*)(ws + WS_WGU); f16* WdT = (f16*)(ws + WS_WD);
    const float* w_g = p.in[I_WG] + (size_t)l * DM * DFF; const float* w_u = p.in[I_WU] + (size_t)l * DM * DFF; const float* w_d = p.in[I_WD] + (size_t)l * DFF * DM;
    const TrPtrs P{w_g, w_u, w_d, nullptr, nullptr, nullptr, WguT, WdT, nullptr, nullptr};
    if (skew && G == 256) { tr_run<1>(bx, 640, 256, scr, P); if (bx >= 128) tr_run<1>(640 + bx - 128, 2112, 128, scr, P); }
    else tr_run<1>(bx, 2112, G, scr, P);
}
__device__ __forceinline__ void sincos_pi(double r, float& s, float& c) {
    const double h = 0.5 * r, h2 = h * h;
    double sh = 1.0 / 355687428096000.0; sh = sh * h2 - 1.0 / 1307674368000.0; sh = sh * h2 + 1.0 / 6227020800.0; sh = sh * h2 - 1.0 / 39916800.0; sh = sh * h2 + 1.0 / 362880.0;
    sh = sh * h2 - 1.0 / 5040.0; sh = sh * h2 + 1.0 / 120.0; sh = sh * h2 - 1.0 / 6.0; sh = sh * h2 + 1.0; sh *= h;
    double ch = -1.0 / 6402373705728000.0; ch = ch * h2 + 1.0 / 20922789888000.0; ch = ch * h2 - 1.0 / 87178291200.0; ch = ch * h2 + 1.0 / 479001600.0; ch = ch * h2 - 1.0 / 3628800.0;
    ch = ch * h2 + 1.0 / 40320.0; ch = ch * h2 - 1.0 / 720.0; ch = ch * h2 + 1.0 / 24.0; ch = ch * h2 - 0.5; ch = ch * h2 + 1.0;
    s = (float)(2.0 * sh * ch); c = (float)(1.0 - 2.0 * sh * sh);
}
__device__ __forceinline__ void prologue(const Params& p, LAS float* scr) {
    const int G = gridDim.x, bx = blockIdx.x, tid = otid(); const long gt = (long)bx * 512 + tid, gs = (long)G * 512;
    f16* XH = (f16*)((unsigned char*)p.out + DO_XH);
    for (long i = gt; i < (long)T * DM / 8; i += gs) {
        const float* src = (i < (long)TP * DM / 8) ? p.in[I_XP] + i * 8 : p.in[I_XS] + (i * 8 - (long)TP * DM);
        const f32x4 a = *(const f32x4*)src, b = *(const f32x4*)(src + 4);
        *(u32x4*)(XH + i * 8) = pack8(a, b);
    }
    float* ssq = (float*)(p.ws + WS_SSQ_Q);
    for (long i = gt; i < 2 * T; i += gs) ssq[i] = 0.f;
    float* cosT = (float*)(p.ws + WS_COS); float* sinT = (float*)(p.ws + WS_SIN);
    for (long i = gt; i < (long)TP * 32; i += gs) {
        const int pos = (int)(i >> 5), j = (int)(i & 31);
        const float ang = (float)pos * p.invf[j];
        const double a = (double)ang, k = rint(a * 0.15915494309189535), r = fma(-k, 6.283185307179586, a) - k * 2.4492935982947064e-16;
        float s, c; sincos_pi(r, s, c); cosT[i] = c; sinT[i] = s;
    }
}

__device__ __forceinline__ void convpool_phase(const Params& p, int l, LAS float* hb) {
    const int G = ogd(), bx = obx(), tid = otid(), wid = tid >> 6, lane = tid & 63;
    LAS float* ob = hb + 62 * 256;
    const f16* U = (const f16*)(p.ws + WS_U); f16* CAT = (f16*)(p.ws + WS_CAT); unsigned char* Kb = p.ws + WS_K;
    const float* cosT = (const float*)(p.ws + WS_COS); const float* sinT = (const float*)(p.ws + WS_SIN);
    const float* w_dw = p.in[I_WDW] + (size_t)l * 31 * 256; const float* b_dw = p.in[I_BDW] + l * 256;
    const float* g_cn = p.in[I_GCN] + l * 256; const float* b_cn = p.in[I_BCN] + l * 256;
    const int c = tid & 255, half = tid >> 8;
    float w[31];
#pragma unroll
    for (int k = 0; k < 31; ++k) w[k] = w_dw[k * 256 + c];
    const float bias = b_dw[c];
    const f32x4 gcn = *(const f32x4*)(g_cn + lane * 4), bcn = *(const f32x4*)(b_cn + lane * 4);
    LAS float* pb = ob + 32 * 256;
    const int g = c >> 6, left = 1 << g, wlen = 2 << g;
#pragma unroll 1
    for (int item = bx; item < T / 32; item += G) {
        const int t0 = item * 32; const int s0 = t0 < TP ? 0 : (TP + ((t0 - TP) & ~4095)), s1 = t0 < TP ? TP : s0 + 4096;
        half8 pv[3], av[4], gv[4];
#pragma unroll
        for (int i = 0; i < 3; ++i) { const int ci = tid + 512 * i, rr = ci >> 5, c8 = (ci & 31) * 8, t = t0 - 8 + rr; pv[i] = half8{};
            if (ci < 47 * 32 && t >= s0 && t < s1) pv[i] = *(const half8*)(U + (size_t)t * LDU + 512 + c8); }
#pragma unroll
        for (int i = 0; i < 4; ++i) { const int ci = tid + 512 * i, rr = ci >> 5, c8 = (ci & 31) * 8, t = t0 - 15 + rr; av[i] = half8{}; gv[i] = half8{};
            if (ci < 62 * 32 && t >= s0 && t < s1) { av[i] = *(const half8*)(U + (size_t)t * LDU + c8); gv[i] = *(const half8*)(U + (size_t)t * LDU + 256 + c8); } }
        { const int tt = tid >> 4, q4 = (tid & 15) * 4, t = t0 + tt, pos = posof(t);
          const half4 x = *(const half4*)(U + (size_t)t * LDU + 1152 + q4);
          const f32x2 c2 = *(const f32x2*)(cosT + pos * 32 + (q4 >> 1)), s2 = *(const f32x2*)(sinT + pos * 32 + (q4 >> 1));
          const float a0 = (float)x[0], a1 = (float)x[1], a2 = (float)x[2], a3 = (float)x[3];
          const unsigned w2 = pk4_fp8(a0 * c2[0] - a1 * s2[0], a0 * s2[0] + a1 * c2[0], a2 * c2[1] - a3 * s2[1], a2 * s2[1] + a3 * c2[1]);
          unsigned char* kp = Kb + (size_t)t * LDK + 128 + q4;
#pragma unroll
          for (int h = 0; h < 4; ++h) *(unsigned*)(kp + 192 * h) = w2; }
#pragma unroll
        for (int i = 0; i < 3; ++i) { const int ci = tid + 512 * i; if (ci < 47 * 32) { LAS float* d = pb + (ci >> 5) * 256 + (ci & 31) * 8;
            *(LAS f32x4*)d = (f32x4){(float)pv[i][0], (float)pv[i][1], (float)pv[i][2], (float)pv[i][3]}; *(LAS f32x4*)(d + 4) = (f32x4){(float)pv[i][4], (float)pv[i][5], (float)pv[i][6], (float)pv[i][7]}; } }
#pragma unroll
        for (int i = 0; i < 4; ++i) { const int ci = tid + 512 * i; if (ci < 62 * 32) { LAS float* d = hb + (ci >> 5) * 256 + (ci & 31) * 8; f32x4 h0, h1;
#pragma unroll
            for (int e = 0; e < 4; ++e) { h0[e] = (float)av[i][e] * sigmoidf_((float)gv[i][e]); h1[e] = (float)av[i][4 + e] * sigmoidf_((float)gv[i][4 + e]); }
            *(LAS f32x4*)d = h0; *(LAS f32x4*)(d + 4) = h1; } }
        __syncthreads();
        { const int tt0 = half * 16; float sum = 0.f;
#pragma unroll
          for (int k = 0; k < 16; ++k) if (k < wlen) sum += pb[(tt0 + 8 - left + k) * 256 + c];
#pragma unroll 4
          for (int q = 0; q < 16; ++q) { const int tt = tt0 + q, t = t0 + tt;
              const int lo = max(t - left, s0), hi = min(t + wlen - left, s1);
              const float d = sum / (float)(hi - lo) - pb[(tt + 8) * 256 + c];
              CAT[(size_t)t * LDC + 256 + c] = (f16)d;
              sum += pb[(tt + 8 - left + wlen) * 256 + c] - pb[(tt + 8 - left) * 256 + c]; } }
#pragma unroll 1
        for (int qg = 0; qg < 2; ++qg) { const int tb = half * 16 + qg * 8;
            float win[38];
#pragma unroll
            for (int i = 0; i < 38; ++i) win[i] = hb[(tb + i) * 256 + c];
#pragma unroll
            for (int q = 0; q < 8; ++q) { float a = bias;
#pragma unroll
                for (int k = 0; k < 31; ++k) a += w[k] * win[q + k];
                ob[(tb + q) * 256 + c] = a; } }
        __syncthreads();
#pragma unroll
        for (int q = 0; q < 4; ++q) { const int tt = wid * 4 + q; f32x4 v = *(const LAS f32x4*)(ob + tt * 256 + lane * 4);
            const float mean = wave_sum((v[0] + v[1]) + (v[2] + v[3])) * (1.0f / 256.0f);
            v = v - mean;
            const float var = wave_sum((v[0] * v[0] + v[1] * v[1]) + (v[2] * v[2] + v[3] * v[3])) * (1.0f / 256.0f);
            const float rstd = 1.0f / sqrtf(var + LN_EPS);
            f32x4 y = v * rstd * gcn + bcn;
#pragma unroll
            for (int e = 0; e < 4; ++e) y[e] = y[e] * sigmoidf_(y[e]);
            u32x2 o2; o2.x = cvtpk(y[0], y[1]); o2.y = cvtpk(y[2], y[3]);
            *(u32x2*)(CAT + (size_t)(t0 + tt) * LDC + lane * 4) = o2; }
        __syncthreads();
    }
}

__device__ __forceinline__ void ln_pass_f16(f16* buf, const float* g, const float* b) {
    const int tid_ = otid(), lane = tid_ & 63, wv = obx() * 8 + (tid_ >> 6), nw = ogd() * 8;
    const f32x4 g0 = *(const f32x4*)(g + lane * 8), g1 = *(const f32x4*)(g + lane * 8 + 4), g2 = *(const f32x4*)(g + 512 + lane * 8), g3 = *(const f32x4*)(g + 512 + lane * 8 + 4);
    const f32x4 b0 = *(const f32x4*)(b + lane * 8), b1 = *(const f32x4*)(b + lane * 8 + 4), b2 = *(const f32x4*)(b + 512 + lane * 8), b3 = *(const f32x4*)(b + 512 + lane * 8 + 4);
#pragma unroll 1
    for (int row = wv; row < T; row += 4 * nw) {
        half8 x0[4], x1[4];
#pragma unroll
        for (int j = 0; j < 4; ++j) { const int r = row + j * nw; x0[j] = half8{}; x1[j] = half8{};
            if (r < T) { const f16* rp = buf + (size_t)r * DM + lane * 8; x0[j] = *(const half8*)rp; x1[j] = *(const half8*)(rp + 512); } }
#pragma unroll
        for (int j = 0; j < 4; ++j) { const int r = row + j * nw; if (r >= T) break;
            f32x4 v0, v1, v2, v3;
#pragma unroll
            for (int e = 0; e < 4; ++e) { v0[e] = (float)x0[j][e]; v1[e] = (float)x0[j][4 + e]; v2[e] = (float)x1[j][e]; v3[e] = (float)x1[j][4 + e]; }
            f32x4 s4 = (v0 + v1) + (v2 + v3);
            const float mean = wave_sum((s4[0] + s4[1]) + (s4[2] + s4[3])) * (1.0f / DM);
            v0 = v0 - mean; v1 = v1 - mean; v2 = v2 - mean; v3 = v3 - mean;
            f32x4 q4 = (v0 * v0 + v1 * v1) + (v2 * v2 + v3 * v3);
            const float rstd = 1.0f / sqrtf(wave_sum((q4[0] + q4[1]) + (q4[2] + q4[3])) * (1.0f / DM) + LN_EPS);
            f16* rp = buf + (size_t)r * DM + lane * 8;
            *(u32x4*)rp = pack8(v0 * rstd * g0 + b0, v1 * rstd * g1 + b1);
            *(u32x4*)(rp + 512) = pack8(v2 * rstd * g2 + b2, v3 * rstd * g3 + b3);
        }
    }
}
__device__ __forceinline__ void ln_pass_f32(float* buf, const float* g, const float* b) {
    const int tid_ = otid(), lane = tid_ & 63, wv = obx() * 8 + (tid_ >> 6), nw = ogd() * 8;
    for (int row = wv; row < T; row += nw) {
        float* rp = buf + (size_t)row * DM + lane * 4;
        f32x4 v[4]; f32x4 s4 = {0.f, 0.f, 0.f, 0.f};
#pragma unroll
        for (int j = 0; j < 4; ++j) { v[j] = *(const f32x4*)(rp + 256 * j); s4 = s4 + v[j]; }
        const float mean = wave_sum((s4[0] + s4[1]) + (s4[2] + s4[3])) * (1.0f / DM);
        f32x4 q4 = {0.f, 0.f, 0.f, 0.f};
#pragma unroll
        for (int j = 0; j < 4; ++j) { v[j] = v[j] - mean; q4 = q4 + v[j] * v[j]; }
        const float rstd = 1.0f / sqrtf(wave_sum((q4[0] + q4[1]) + (q4[2] + q4[3])) * (1.0f / DM) + LN_EPS);
#pragma unroll
        for (int j = 0; j < 4; ++j) { const f32x4 gg = *(const f32x4*)(g + lane * 4 + 256 * j), bb = *(const f32x4*)(b + lane * 4 + 256 * j);
            *(f32x4*)(rp + 256 * j) = v[j] * rstd * gg + bb; }
    }
}

#define XB_TMO      128
#define XB_XCNT(j)  (256  + 64 * (j))
#define XB_XSUB(j)  (1280 + 64 * (j))
#define XB_XGEN(j)  (2304 + 64 * (j))
#define XB_TOP      3328
#define XB_TOPGEN   3392
#define XCD_BAR_WORDS 3456
#define XB_SPIN_CAP (1u << 18)

__device__ __forceinline__ unsigned xb_ld(unsigned* p)              { return __hip_atomic_load(p, __ATOMIC_RELAXED, __HIP_MEMORY_SCOPE_AGENT); }
__device__ __forceinline__ unsigned xb_add(unsigned* p, unsigned v) { return __hip_atomic_fetch_add(p, v, __ATOMIC_RELAXED, __HIP_MEMORY_SCOPE_AGENT); }
__device__ __forceinline__ unsigned xb_xcc_id() { return (unsigned)__builtin_amdgcn_s_getreg((3 << 11) | 20) & 0xFu; }
#define XB_SPIN(cond, bar) do { unsigned _sp = 0; while (cond) { __builtin_amdgcn_s_sleep(1); \
    if ((++_sp & 255u) == 0u) { if (xb_ld(&(bar)[XB_TMO])) break; if (_sp > XB_SPIN_CAP) { atomicAdd(&(bar)[XB_TMO], 1u); break; } } } } while (0)

struct XcdBarrier {
    unsigned* bar; unsigned x;
    volatile LAS unsigned* st;
};

__device__ __forceinline__ XcdBarrier xcd_barrier_post(unsigned* bar, volatile LAS unsigned* st) {
    XcdBarrier b; b.bar = bar; b.x = xb_xcc_id(); b.st = st;
    if (threadIdx.x == 0) (void)xb_add(&bar[XB_XCNT(b.x)], 1u);
    return b;
}
__device__ __forceinline__ void xcd_barrier_complete(unsigned* bar, unsigned x, unsigned& nloc, unsigned& nx) {
    const unsigned G = gridDim.x * gridDim.y * gridDim.z;
    unsigned sum, cnt, mine, sp = 0u;
    for (;;) {
        sum = 0u; cnt = 0u; mine = 0u;
#pragma unroll
        for (unsigned j = 0; j < 16; ++j) { const unsigned c = xb_ld(&bar[XB_XCNT(j)]); sum += c; cnt += (c > 0u) ? 1u : 0u; mine = (j == x) ? c : mine; }
        if (sum == G) break;
        __builtin_amdgcn_s_sleep(1);
        if ((++sp & 255u) == 0u) { if (xb_ld(&bar[XB_TMO])) break; if (sp > XB_SPIN_CAP) { atomicAdd(&bar[XB_TMO], 1u); break; } }
    }
    nloc = mine > 0u ? mine : 1u; nx = cnt > 0u ? cnt : 1u;
}

__device__ __forceinline__ void xcd_barrier(const XcdBarrier& b) {
    asm volatile("s_waitcnt vmcnt(0)" ::: "memory");
    __syncthreads();
    if (threadIdx.x == 0) {
        unsigned* bar = b.bar;
        __builtin_amdgcn_s_waitcnt(0);
        unsigned nloc = b.st[0], nx = b.st[1];
        if (nloc == 0u) { xcd_barrier_complete(bar, b.x, nloc, nx); b.st[0] = nloc; b.st[1] = nx; }
        const unsigned old = xb_add(&bar[XB_XSUB(b.x)], 1u);
        const unsigned gen = old / nloc;
        if (old + 1u == (gen + 1u) * nloc) {
            __builtin_amdgcn_fence(__ATOMIC_RELEASE, "agent");
            asm volatile("s_waitcnt vmcnt(0)" ::: "memory");
            const unsigned og = xb_add(&bar[XB_TOP], 1u);
            const unsigned tg = og / nx;
            if (og + 1u == (tg + 1u) * nx) xb_add(&bar[XB_TOPGEN], 1u);
            else XB_SPIN(xb_ld(&bar[XB_TOPGEN]) == tg, bar);
            __builtin_amdgcn_fence(__ATOMIC_ACQUIRE, "agent");
            xb_add(&bar[XB_XGEN(b.x)], 1u);
            asm volatile("s_waitcnt vmcnt(0)" ::: "memory");
        } else {
            XB_SPIN(xb_ld(&bar[XB_XGEN(b.x)]) == gen, bar);
            __builtin_amdgcn_fence(__ATOMIC_ACQUIRE, "agent");
            asm volatile("s_waitcnt vmcnt(0)" ::: "memory");
        }
    }
    __syncthreads();
}


constexpr int CONV_LDS = (62 + 32 + 47) * 256 * 4 + 1024, GEMM_LDS = pg8::STAGE_BYTES + 12288;
constexpr int LDS_BYTES0 = att::SHM_TOTAL > GEMM_LDS ? att::SHM_TOTAL : GEMM_LDS, LDS_BYTES = LDS_BYTES0 > CONV_LDS ? LDS_BYTES0 : CONV_LDS;
static_assert(att::SHM_TOTAL <= LDS_BYTES && (62 + 32 + 47) * 256 * 4 <= LDS_BYTES, "LDS");
constexpr int NSUB = 8, N_PHASES = 1 + NSUB * NL;
#ifndef PHB
#define PHB 7
#endif
#ifndef PHM
#define PHM 511
#endif

__global__ void __launch_bounds__(512, 2) mega_fwd(Params p) {
    extern __shared__ __attribute__((aligned(16))) unsigned char lds_raw[];
    LAS unsigned char* lds = (LAS unsigned char*)lds_raw;
    cg::grid_group grid = cg::this_grid();
    volatile LAS unsigned* xst = (volatile LAS unsigned*)(lds + LDS_BYTES);
    if (threadIdx.x < 4) xst[threadIdx.x] = 0u;
    __syncthreads();
    unsigned* barw = (unsigned*)(p.ws + WS_BAR);
    if (p.ph_lo == 0) {
        if (blockIdx.x == 0) for (int i = threadIdx.x; i < XCD_BAR_WORDS; i += 512) barw[i] = 0u;
        if (PHM & 1) prologue(p, (LAS float*)lds);
        if (p.ph_hi > 1) grid.sync(); }
    XcdBarrier xb; xb.bar = barw; xb.x = 0; xb.st = xst;
    if (p.ph_hi - p.ph_lo > 1) xb = xcd_barrier_post(barw, xst);
    for (int ph_ = p.ph_lo; ph_ < p.ph_hi; ++ph_) {
        int ph = __builtin_amdgcn_readfirstlane(ph_); asm volatile("" : "+s"(ph));
        int sub = -1; const int G = ogd(), bx = obx();
        Params q;
#pragma unroll
        for (int i = 0; i < 22; ++i) { const float* t = p.in[i]; asm volatile("" : "+s"(t)); q.in[i] = t; }
        { float* t = p.out; asm volatile("" : "+s"(t)); q.out = t; } { unsigned char* t = p.ws; asm volatile("" : "+s"(t)); q.ws = t; }
        unsigned char* ws = q.ws; unsigned char* outb = (unsigned char*)q.out;
        f16* XH = (f16*)(outb + DO_XH); unsigned char* Qb = outb + DO_Q;
        f16* U = (f16*)(ws + WS_U); f16* X1H = (f16*)(ws + WS_U); f16* Hb = (f16*)(ws + WS_H);
        unsigned char* Kb = ws + WS_K; unsigned char* Vb = ws + WS_V; f16* CAT = (f16*)(ws + WS_CAT);
        float* ssq_q = (float*)(ws + WS_SSQ_Q); float* ssq_kv = (float*)(ws + WS_SSQ_KV);
        const float* cosT = (const float*)(ws + WS_COS); const float* sinT = (const float*)(ws + WS_SIN);
        const f16* WinT = (const f16*)(ws + WS_WIN); const f16* WuqT = (const f16*)(ws + WS_WUQ); const f16* WukvT = (const f16*)(ws + WS_WUKV); const f16* WoutT = (const f16*)(ws + WS_WOUT);
        const f16* WguT = (const f16*)(ws + WS_WGU); const f16* WdT = (const f16*)(ws + WS_WD);
        if (ph == 0) { conv_weights_A(q, 0, (LAS float*)lds); conv_weights_F(q, 0, (LAS float*)lds); }
        else {
            const int l = (ph - 1) / NSUB; sub = (ph - 1) % NSUB;
            unsigned* cnt = (unsigned*)(ws + WS_CNT); unsigned long long* xbuf = (unsigned long long*)(ws + WS_XBUF);
            if (sub == 0 && (PHM & 2)) {
                for (int i = bx * 512 + otid(); i < 2 * 128 * 64; i += G * 512) cnt[i] = 0u;
                if (l > 0) conv_weights_F(q, l, (LAS float*)lds, true);
                pg8::Gemm g{XH, WinT, DM, DM, T, DINP, DM}; pg8::StaticOrder S; S.init(T, DINP, G, bx);
                EpiA E{U, ssq_q, ssq_kv};
                pg8::gemm_phase<EpiA>(lds, g, S, E);
            } else if (sub == 1 && (PHM & 4) && (PHB & 1)) {
                { pg8::Gemm g{U + 768, WuqT, LDU, 256, T, 768, 256}; pg8::StaticOrder S; S.init(T, 768, G, bx);
                  EpiQ E{Qb, ssq_q, cosT, sinT}; pg8::gemm_phase<EpiQ>(lds, g, S, E); }
            } else if (sub == 2 && (PHM & 4) && (PHB & 2)) {
                { pg8::Gemm g{U + 1024, WukvT, LDU, 128, T, 1024, 128}; pg8::StaticOrder S; S.init(T, 1024, G, bx);
                  EpiKV E{Kb, Vb, ssq_kv}; pg8::gemm_phase<EpiKV>(lds, g, S, E); }
            } else if (sub == 3 && (PHM & 4) && (PHB & 4)) {
                convpool_phase(q, l, (LAS float*)lds);
            } else if (sub == 4 && (PHM & 8)) {
                for (int uidx = bx; uidx < 512; uidx += G) {
                    const int v = uidx & 255, xcd = v & 7, slot = v >> 3;
                    int row0, h, seq0, seqlen;
                    if (uidx < 256) { h = xcd >> 1; const int qb = (xcd & 1) * 32 + slot; seq0 = 0; seqlen = TP; row0 = qb * 256; }
                    else { const int sq = xcd >> 1; h = 2 * (xcd & 1) + (slot >> 4); const int qb = slot & 15; seq0 = TP + sq * 4096; seqlen = 4096; row0 = seq0 + qb * 256; }
                    att::attn_unit(Qb + (size_t)row0 * LDQ + 192 * h, Kb + (size_t)seq0 * LDK + 192 * h, Vb + ((size_t)h * (T / 64) + (seq0 >> 6)) * (128 * 64),
                                      CAT + (size_t)row0 * LDC + 512 + 128 * h, seqlen, (LAS char*)lds);
                }
            } else if (sub == 5 && (PHM & 16)) {
                pg8::Gemm g{CAT, WoutT, DM, DM, T, DM, DM}; pg8::StaticOrder S; S.init(T, DM, G, bx); S.panel = (G != 256);
                EpiResLN<false> E{XH, X1H, nullptr, q.in[I_LN1G] + l * DM, q.in[I_LN1B] + l * DM, xbuf, cnt}; pg8::gemm_phase<EpiResLN<false>>(lds, g, S, E);
            } else if (sub == 6 && (PHM & 64)) {
                for (long i = (long)bx * 512 + otid(); i < 2 * T; i += (long)G * 512) ssq_q[i] = 0.f;
                if (l + 1 < NL) conv_weights_A(q, l + 1, (LAS float*)lds);
                pg8::Gemm g{X1H, WguT, DM, DM, T, 2 * DFF, DM}; pg8::StaticOrder S; S.init(T, 2 * DFF, G, bx);
                EpiGLU E{Hb}; pg8::gemm_phase<EpiGLU>(lds, g, S, E);
            } else if (sub == 7 && (PHM & 128)) {
                pg8::Gemm g{Hb, WdT, DFF, DFF, T, DM, DFF}; pg8::StaticOrder S; S.init(T, DM, G, bx); S.panel = (G != 256);
                if (l == NL - 1) { EpiResLN<true> E{X1H, nullptr, q.out, q.in[I_LN2G] + l * DM, q.in[I_LN2B] + l * DM, xbuf, cnt + 128 * 64}; pg8::gemm_phase<EpiResLN<true>>(lds, g, S, E); }
                else { EpiResLN<false> E{X1H, XH, nullptr, q.in[I_LN2G] + l * DM, q.in[I_LN2B] + l * DM, xbuf, cnt + 128 * 64}; pg8::gemm_phase<EpiResLN<false>>(lds, g, S, E); }
            }
        }
        if (ph_ + 1 < p.ph_hi) { if (sub == 1 || sub == 2) __syncthreads(); else { XcdBarrier xl = xb; xl.x = __builtin_amdgcn_readfirstlane(xb_xcc_id()); asm volatile("" : "+s"(xl.bar), "+s"(xl.x)); xcd_barrier(xl);     } }
    }
}

extern "C" void kernel_launch(void* const* d_in, const int* in_sizes, int n_in, void* d_out, int out_size, void* d_ws, size_t ws_size, hipStream_t stream) {
    static int grid_blocks = 0;
    if (grid_blocks == 0) {
        if (n_in != 22 || out_size != T * DM || ws_size < WS_END) { fprintf(stderr, "kernel_launch: unexpected shapes n_in %d out %d ws %zu\n", n_in, out_size, ws_size); grid_blocks = -1; return; }
        int dev = 0, cus = 0, per_cu = 0;
        hipGetDevice(&dev); hipDeviceGetAttribute(&cus, hipDeviceAttributeMultiprocessorCount, dev);
        if (hipFuncSetAttribute((const void*)mega_fwd, hipFuncAttributeMaxDynamicSharedMemorySize, LDS_BYTES + 16) != hipSuccess) { fprintf(stderr, "hipFuncSetAttribute failed\n"); grid_blocks = -1; return; }
        hipOccupancyMaxActiveBlocksPerMultiprocessor(&per_cu, (const void*)mega_fwd, 512, LDS_BYTES + 16);
        if (per_cu < 1) per_cu = 1;
        grid_blocks = cus * per_cu;
        (void)hipGetLastError();
    }
    if (grid_blocks < 0) return;
    Params p{};
    for (int i = 0; i < 22; ++i) p.in[i] = (const float*)d_in[i];
    p.out = (float*)d_out; p.ws = (unsigned char*)d_ws;
    for (int j = 0; j < 32; ++j) { const float e = (float)(2 * j) / 64.0f; p.invf[j] = 1.0f / powf(10000.0f, e); }
    p.ph_lo = 0; p.ph_hi = N_PHASES;
    void* args[] = {&p};
    hipError_t e = hipLaunchCooperativeKernel((const void*)mega_fwd, dim3(grid_blocks), dim3(512), args, LDS_BYTES + 16, stream);
    if (e != hipSuccess) {
        fprintf(stderr, "cooperative launch failed: %s (grid %d); falling back to one launch per phase\n", hipGetErrorString(e), grid_blocks);
        (void)hipGetLastError();
        for (int ph = 0; ph < N_PHASES; ++ph) { p.ph_lo = ph; p.ph_hi = ph + 1; hipLaunchKernelGGL(mega_fwd, dim3(grid_blocks), dim3(512), LDS_BYTES + 16, stream, p); }
    }
}
```
